# Optimizing an MI355X kernel written in HIP

```python
import jax, jax.numpy as jnp
from jax import lax
import numpy as np

D_MODEL = 1024
BATCH = 32
SEQ = 2048
DEPTH = 1

N_HEADS = 16
HEAD_DIM = D_MODEL // N_HEADS
D_ATTN = N_HEADS * HEAD_DIM
BLOCK_Q = 128
SB_SCALE = HEAD_DIM ** -0.5
POOL_WINDOWS = (2, 4, 8, 16)
N_POOL_GROUPS = len(POOL_WINDOWS)
D_POOL = D_MODEL
POOL_GROUP_DIM = D_POOL // N_POOL_GROUPS
SPLITS = (D_ATTN, D_ATTN, D_ATTN, D_ATTN, D_POOL, D_POOL, D_MODEL, D_MODEL)
IN_COLS = sum(SPLITS)
EPS = 1e-6

kernel_name = "hybrid_stickbreak_pool_block"


def rms_norm(x, gain):
    xf = x.astype(jnp.float32)
    y = xf * lax.rsqrt(jnp.mean(xf * xf, axis=-1, keepdims=True) + EPS)
    return (y * gain.astype(jnp.float32)).astype(x.dtype)


def stick_breaking_attention(q, k, v):
    S = q.shape[2]
    outs = []
    for i in range(S // BLOCK_Q):
        q0, q1 = i * BLOCK_Q, (i + 1) * BLOCK_Q
        qb = q[:, :, q0:q1]
        kb = k[:, :, :q1]
        vb = v[:, :, :q1]
        z = jnp.einsum('bhqd,bhkd->bhqk', qb, kb).astype(jnp.float32) * SB_SCALE
        q_pos = jnp.arange(q0, q1)[:, None]
        k_pos = jnp.arange(q1)[None, :]
        mask = k_pos < q_pos
        log_1m_beta = jnp.where(mask, -jax.nn.softplus(z), 0.0)
        suffix = lax.cumsum(log_1m_beta, axis=3, reverse=True) - log_1m_beta
        w = jnp.where(mask, jnp.exp(jax.nn.log_sigmoid(z) + suffix), 0.0)
        outs.append(jnp.einsum('bhqk,bhkd->bhqd', w.astype(vb.dtype), vb))
    return jnp.concatenate(outs, axis=2)


def multiscale_causal_pool(u, pool_w, pool_scale):
    B, S, _ = u.shape
    uf = u.astype(jnp.float32)
    pos_count = jnp.arange(S) + 1
    diffs = []
    for g, win in enumerate(POOL_WINDOWS):
        ug = uf[:, :, g * POOL_GROUP_DIM:(g + 1) * POOL_GROUP_DIM]
        cs = jnp.cumsum(ug, axis=1)
        cs_shift = jnp.pad(cs, ((0, 0), (win, 0), (0, 0)))[:, :S]
        count = jnp.minimum(pos_count, win).astype(jnp.float32)[None, :, None]
        diffs.append((cs - cs_shift) / count - ug)
    d = jnp.stack(diffs, axis=2).astype(u.dtype)
    mixed = jnp.einsum('bsgc,gcd->bsgd', d, pool_w).reshape(B, S, D_POOL)
    return mixed * pool_scale


def hybrid_layer(x, c, norm_gain, w_ada, b_ada, w_in, pool_w, pool_scale,
                 w_branch_a, w_branch_b, w_out):
    B, S, D = x.shape
    mod = jax.nn.silu(c) @ w_ada + b_ada
    shift, scale, gate = jnp.split(mod, 3, axis=-1)
    h = rms_norm(x, norm_gain) * (1.0 + scale[:, None, :]) + shift[:, None, :]

    proj = h @ w_in
    offs = np.cumsum(SPLITS)[:-1].tolist()
    q, k, v, z_a, u, z_b, m_a, m_b = jnp.split(proj, offs, axis=-1)

    to_heads = lambda t: t.reshape(B, S, N_HEADS, HEAD_DIM).transpose(0, 2, 1, 3)
    attn = stick_breaking_attention(to_heads(q), to_heads(k), to_heads(v))
    attn = attn.transpose(0, 2, 1, 3).reshape(B, S, D_ATTN)
    p_a = (attn * jax.nn.silu(z_a)) @ w_branch_a

    pooled = multiscale_causal_pool(u, pool_w, pool_scale)
    p_b = (pooled * jax.nn.silu(z_b)) @ w_branch_b

    merged = jax.nn.sigmoid(m_a) * p_a + jax.nn.sigmoid(m_b) * p_b
    out = merged @ w_out
    return x + gate[:, None, :] * out


def setup_inputs(seed: int = 0) -> dict:
    key = jax.random.key(seed)
    ks = jax.random.split(key, 13)
    f32 = jnp.float32
    nrm = lambda k, shape, s: jax.random.normal(k, shape, f32) * s
    return {
        "x": nrm(ks[0], (BATCH, SEQ, D_MODEL), 1.0),
        "c": nrm(ks[1], (BATCH, D_MODEL), 1.0),
        "norm_gain": 1.0 + nrm(ks[2], (DEPTH, D_MODEL), 0.05),
        "w_ada": nrm(ks[3], (DEPTH, D_MODEL, 3 * D_MODEL), 0.5 * D_MODEL ** -0.5),
        "b_ada": nrm(ks[4], (DEPTH, 3 * D_MODEL), 0.01),
        "w_in": nrm(ks[5], (DEPTH, D_MODEL, IN_COLS), D_MODEL ** -0.5),
        "pool_w": nrm(ks[6], (DEPTH, N_POOL_GROUPS, POOL_GROUP_DIM, POOL_GROUP_DIM), POOL_GROUP_DIM ** -0.5),
        "pool_scale": 1.0 + nrm(ks[7], (DEPTH, D_POOL), 0.1),
        "w_branch_a": nrm(ks[8], (DEPTH, D_ATTN, D_MODEL), D_ATTN ** -0.5),
        "w_branch_b": nrm(ks[9], (DEPTH, D_POOL, D_MODEL), D_POOL ** -0.5),
        "w_out": nrm(ks[10], (DEPTH, D_MODEL, D_MODEL), D_MODEL ** -0.5),
        "final_gain": 1.0 + nrm(ks[11], (D_MODEL,), 0.05),
    }


def reference(x, c, norm_gain, w_ada, b_ada, w_in, pool_w, pool_scale,
              w_branch_a, w_branch_b, w_out, final_gain):
    for l in range(DEPTH):
        x = hybrid_layer(x, c, norm_gain[l], w_ada[l], b_ada[l], w_in[l], pool_w[l],
                         pool_scale[l], w_branch_a[l], w_branch_b[l], w_out[l])
    return rms_norm(x, final_gain)
```

```cpp
#include <hip/hip_runtime.h>
#include <hip/hip_cooperative_groups.h>
#include <cstdio>
#include <cstdint>
namespace cg = cooperative_groups;

namespace pg8 {
#define PG8_LAS __attribute__((address_space(3)))
typedef unsigned short bf16_t;
typedef short bf16x8 __attribute__((ext_vector_type(8)));
typedef float f32x4 __attribute__((ext_vector_type(4)));
typedef unsigned u32x4 __attribute__((ext_vector_type(4)));
typedef unsigned u32x2 __attribute__((ext_vector_type(2)));
constexpr int BM = 256, BK = 64, HALF = 128, HTB = HALF * BK * 2  , STAGE_BYTES = 8 * HTB, NXCD = 8, WGM = 8;

__host__ __device__ __forceinline__ int lds_byte(int r, int c) { const int st = (r >> 4) * 2 + (c >> 5), rr = r & 15, cc = c & 31, ob = rr * 64 + cc * 2; return st * 1024 + (ob ^ (((ob >> 9) & 1) << 5)); }
__host__ __device__ __forceinline__ void stage_rc(int b, int& R, int& C) { const int st = b / 1024, sb = b % 1024, swz = sb ^ (((sb >> 9) & 1) << 5); R = (st >> 1) * 16 + swz / 64; C = (st & 1) * 32 + (swz % 64) / 2; }
__host__ __device__ __forceinline__ int perm32(int rho) { const int n = rho >> 4, i = rho & 15; return 8 * (i >> 2) + 4 * n + (i & 3); }

struct Unit { int pm, pn, sel; };
struct Gemm { const bf16_t* A0; const bf16_t* A1; const bf16_t* B0; const bf16_t* B1; int M, N, K; };

struct StaticOrder {
    int nM, nN, nwg, G, c, pair;
    __host__ __device__ void init(int M, int N, int G_, int c_, int pair_) { nM = M / BM; nN = N / BM; nwg = nM * nN; G = G_; c = c_; pair = pair_; }
    __host__ __device__ bool next(int ii, Unit& u) const {
        const int i = pair ? (ii >> 1) : ii; u.sel = pair ? (ii & 1) : 0;
        const long L = (long)i * G + c; if (L >= nwg) return false;
        int wgid = (int)L; { const int q = nwg / NXCD, r = nwg % NXCD, xcd = wgid % NXCD, off = wgid / NXCD; wgid = (xcd < r ? xcd * (q + 1) : r * (q + 1) + (xcd - r) * q) + off; }
        const int nig = WGM * nN, gid = wgid / nig, fm = gid * WGM, gsz = (nM - fm) < WGM ? (nM - fm) : WGM;
        u.pm = fm + ((wgid % nig) % gsz); u.pn = (wgid % nig) / gsz; return true;
    }
};

__device__ __forceinline__ unsigned cvt_pk_bf16(float lo, float hi) { unsigned r; asm("v_cvt_pk_bf16_f32 %0, %1, %2" : "=v"(r) : "v"(lo), "v"(hi)); return r; }
__device__ __forceinline__ float bf_lo(unsigned w) { return __uint_as_float(w << 16); }
__device__ __forceinline__ float bf_hi(unsigned w) { return __uint_as_float(w & 0xffff0000u); }
__device__ __forceinline__ float fast_sigmoid(float x) { return __builtin_amdgcn_rcpf(1.0f + __expf(-x)); }

constexpr int PROJ_ROWS = 32768;
constexpr size_t SEG_ELEMS = (size_t)PROJ_ROWS * 1024;
struct EpiProj {
    static constexpr bool PERM = true, PAIR = false;
    bf16_t* P;
    __device__ __forceinline__ void operator()(f32x4 (&acc)[2][2][4][2], const Unit& u, int wr, int wc, int fr, int fq) const {
        const int sg = u.pn >> 2, colt = (u.pn & 3) * BM;
        const int row0 = u.pm * BM + wr * 64 + fr, col0 = colt + wc * 32 + 8 * fq;
        bf16_t* base = P + (size_t)sg * SEG_ELEMS;
        if (sg == 2) {
#pragma unroll
            for (int ai = 0; ai < 2; ++ai)
#pragma unroll
                for (int m = 0; m < 4; ++m) { const int r = row0 + ai * HALF + m * 16; bf16_t* vp = base + ((size_t)(r >> 11) * 1024 + col0) * 2048 + (r & 2047);
#pragma unroll
                    for (int bj = 0; bj < 2; ++bj)
#pragma unroll
                        for (int n = 0; n < 2; ++n)
#pragma unroll
                            for (int j = 0; j < 4; ++j) { const float v = acc[ai][bj][m][n][j]; vp[(size_t)(bj * HALF + 4 * n + j) * 2048] = (bf16_t)(cvt_pk_bf16(v, v) & 0xffffu); } }
        } else {
            const int act = (sg == 3 || sg == 5) ? 1 : (sg >= 6 ? 2 : 0);
#pragma unroll
            for (int ai = 0; ai < 2; ++ai)
#pragma unroll
                for (int m = 0; m < 4; ++m) { bf16_t* rowp = base + (size_t)(row0 + ai * HALF + m * 16) * 1024 + col0;
#pragma unroll
                    for (int bj = 0; bj < 2; ++bj) { f32x4 v0 = acc[ai][bj][m][0], v1 = acc[ai][bj][m][1];
                        if (act) {
#pragma unroll
                            for (int j = 0; j < 4; ++j) { const float s0 = fast_sigmoid(v0[j]), s1 = fast_sigmoid(v1[j]); v0[j] = (act == 1) ? v0[j] * s0 : s0; v1[j] = (act == 1) ? v1[j] * s1 : s1; } }
                        u32x4 w; w.x = cvt_pk_bf16(v0[0], v0[1]); w.y = cvt_pk_bf16(v0[2], v0[3]); w.z = cvt_pk_bf16(v1[0], v1[1]); w.w = cvt_pk_bf16(v1[2], v1[3]);
                        *(u32x4*)(rowp + bj * HALF) = w; } }
        }
    }
};
struct EpiMerge {
    static constexpr bool PERM = true, PAIR = true;
    const bf16_t* SA; const bf16_t* SB; bf16_t* O;
    __device__ __forceinline__ void operator()(f32x4 (&acc)[2][2][4][2], const Unit& u, int wr, int wc, int fr, int fq) const {
        const int row0 = u.pm * BM + wr * 64 + fr, col0 = u.pn * BM + wc * 32 + 8 * fq;
#pragma unroll
        for (int ai = 0; ai < 2; ++ai)
#pragma unroll
            for (int m = 0; m < 4; ++m) { const size_t off = (size_t)(row0 + ai * HALF + m * 16) * 1024 + col0;
#pragma unroll
                for (int bj = 0; bj < 2; ++bj) {
                    const u32x4 sbw = *(const u32x4*)(SB + off + bj * HALF);
                    float sb[8];
#pragma unroll
                    for (int j = 0; j < 4; ++j) { sb[2 * j] = fmaxf(bf_lo(sbw[j]), 1e-30f); sb[2 * j + 1] = fmaxf(bf_hi(sbw[j]), 1e-30f); }
                    if (u.sel == 0) {
                        const u32x4 saw = *(const u32x4*)(SA + off + bj * HALF);
#pragma unroll
                        for (int j = 0; j < 4; ++j) { const float r0 = bf_lo(saw[j]) * __builtin_amdgcn_rcpf(sb[2 * j]), r1 = bf_hi(saw[j]) * __builtin_amdgcn_rcpf(sb[2 * j + 1]);
                            if (j < 2) { acc[ai][bj][m][0][2 * j] *= r0; acc[ai][bj][m][0][2 * j + 1] *= r1; } else { acc[ai][bj][m][1][2 * j - 4] *= r0; acc[ai][bj][m][1][2 * j - 3] *= r1; } }
                    } else {
                        const f32x4 v0 = acc[ai][bj][m][0], v1 = acc[ai][bj][m][1];
                        u32x4 w; w.x = cvt_pk_bf16(v0[0] * sb[0], v0[1] * sb[1]); w.y = cvt_pk_bf16(v0[2] * sb[2], v0[3] * sb[3]); w.z = cvt_pk_bf16(v1[0] * sb[4], v1[1] * sb[5]); w.w = cvt_pk_bf16(v1[2] * sb[6], v1[3] * sb[7]);
                        *(u32x4*)(O + off + bj * HALF) = w; } } }
    }
};
struct EpiOut {
    static constexpr bool PERM = false, PAIR = false;
    const float* x; const float* mod; float* out; int row_off;
    __device__ __forceinline__ void operator()(f32x4 (&acc)[2][2][4][2], const Unit& u, int wr, int wc, int fr, int fq) const {
        const int R0 = row_off + u.pm * BM + wr * 64 + fr, col0 = u.pn * BM + wc * 32 + 4 * fq;
        const float* gate = mod + (size_t)((row_off + u.pm * BM) >> 11) * 3072 + 2048;
        f32x4 gv[2][2];
#pragma unroll
        for (int bj = 0; bj < 2; ++bj)
#pragma unroll
            for (int n = 0; n < 2; ++n) gv[bj][n] = *(const f32x4*)(gate + col0 + bj * HALF + n * 16);
#pragma unroll
        for (int ai = 0; ai < 2; ++ai)
#pragma unroll
            for (int m = 0; m < 4; ++m) { const size_t off = (size_t)(R0 + ai * HALF + m * 16) * 1024 + col0;
#pragma unroll
                for (int bj = 0; bj < 2; ++bj)
#pragma unroll
                    for (int n = 0; n < 2; ++n) { const f32x4 xv = *(const f32x4*)(x + off + bj * HALF + n * 16); *(f32x4*)(out + off + bj * HALF + n * 16) = xv + gv[bj][n] * acc[ai][bj][m][n]; } }
    }
};

template <class Epi, bool ALIGN_EPI, bool SP2>
__device__ __forceinline__ void gemm_phase(PG8_LAS unsigned char* lds, const Gemm g, const StaticOrder& S, const Epi& E) {
    int tid_l = threadIdx.x; asm volatile("" : "+v"(tid_l));
    const int tid = tid_l, wid = __builtin_amdgcn_readfirstlane(tid >> 6), lane = tid & 63, wr = wid >> 2, wc = wid & 3, fr = lane & 15, fq = lane >> 4;
    const int K = g.K, nt = K / BK;
    unsigned voffA[2], voffB[2];
#pragma unroll
    for (int i = 0; i < 2; ++i) { int R, C; stage_rc(tid * 16 + i * 8192, R, C); const int Rb = Epi::PERM ? ((R & ~31) + perm32(R & 31)) : R;
        voffA[i] = (unsigned)(R * K + C) * 2u; voffB[i] = (unsigned)(Rb * K + C) * 2u; }
    const size_t kstep = (size_t)(BK * 2);
    const size_t hstep = (size_t)HALF * K * 2;
    const size_t tstep = 2 * hstep;
    const unsigned ldsw = (unsigned)wid * 1024u;
    const int aoff = lds_byte(wr * 64 + fr, fq * 8), boff = lds_byte(wc * 32 + fr, fq * 8);
#define PG8_SA(b, h) (((b) * 2 + (h)) * HTB)
#define PG8_SB(b, h) ((4 + (b) * 2 + (h)) * HTB)
#define PG8_STAGE(bufoff, gbase, voff) do { _Pragma("unroll") for (int _i = 0; _i < 2; ++_i) \
        __builtin_amdgcn_global_load_lds((const unsigned*)((const char*)(gbase) + (voff)[_i]), (PG8_LAS unsigned*)(lds + (bufoff) + ldsw + _i * 8192), 16, 0, 0); } while (0)
#define PG8_LDA(dst, b, h) do { _Pragma("unroll") for (int m = 0; m < 4; ++m) _Pragma("unroll") for (int k = 0; k < 2; ++k) dst[m][k] = *(const PG8_LAS bf16x8*)(lds + PG8_SA(b, h) + aoff + m * 2048 + k * 1024); } while (0)
#define PG8_LDB(dst, b, h) do { _Pragma("unroll") for (int n = 0; n < 2; ++n) _Pragma("unroll") for (int k = 0; k < 2; ++k) dst[n][k] = *(const PG8_LAS bf16x8*)(lds + PG8_SB(b, h) + boff + n * 2048 + k * 1024); } while (0)
#define PG8_MMA(ai, bj, At, Bt) do { __builtin_amdgcn_s_setprio(1); _Pragma("unroll") for (int m = 0; m < 4; ++m) _Pragma("unroll") for (int n = 0; n < 2; ++n) _Pragma("unroll") for (int k = 0; k < 2; ++k) \
        acc[ai][bj][m][n] = __builtin_amdgcn_mfma_f32_16x16x32_bf16(Bt[n][k], At[m][k], acc[ai][bj][m][n], 0, 0, 0); __builtin_amdgcn_s_setprio(0); } while (0)
#define PG8_WAIT_V(n) asm volatile("s_waitcnt vmcnt(" #n ")" ::: "memory")
#define PG8_WAIT_L(n) asm volatile("s_waitcnt lgkmcnt(" #n ")" ::: "memory")
#define PG8_BAR __builtin_amdgcn_s_barrier()
#define PG8_SCHED __builtin_amdgcn_sched_barrier(0)
    Unit cur, nxt; int ui = 0;
    if (!S.next(0, cur)) return;
    f32x4 acc[2][2][4][2];
#pragma unroll
    for (int a = 0; a < 2; ++a)
#pragma unroll
        for (int b = 0; b < 2; ++b)
#pragma unroll
            for (int m = 0; m < 4; ++m)
#pragma unroll
                for (int n = 0; n < 2; ++n) acc[a][b][m][n] = (f32x4){0.f, 0.f, 0.f, 0.f};
    bf16x8 At[4][2], B0[2][2], B1[2][2];
    const char* cA = (const char*)(cur.sel ? g.A1 : g.A0) + (size_t)cur.pm * tstep; const char* cB = (const char*)(cur.sel ? g.B1 : g.B0) + (size_t)cur.pn * tstep;
    if constexpr (SP2) {
        PG8_STAGE(PG8_SB(0, 0), cB, voffB); PG8_STAGE(PG8_SB(0, 1), cB + hstep, voffB); PG8_STAGE(PG8_SA(0, 0), cA, voffA); PG8_STAGE(PG8_SA(0, 1), cA + hstep, voffA);
        if (wr == 1) PG8_BAR;
        PG8_WAIT_V(2); PG8_BAR;
        PG8_STAGE(PG8_SB(1, 0), cB + kstep, voffB); PG8_STAGE(PG8_SA(1, 0), cA + kstep, voffA); PG8_STAGE(PG8_SB(1, 1), cB + hstep + kstep, voffB);
        PG8_WAIT_V(6); PG8_BAR;
    } else {
        PG8_STAGE(PG8_SB(0, 0), cB, voffB); PG8_STAGE(PG8_SA(0, 0), cA, voffA); PG8_STAGE(PG8_SB(0, 1), cB + hstep, voffB); PG8_STAGE(PG8_SA(0, 1), cA + hstep, voffA);
        if (wr == 1) PG8_BAR;
        PG8_WAIT_V(4); PG8_BAR;
        PG8_STAGE(PG8_SB(1, 0), cB + kstep, voffB); PG8_STAGE(PG8_SA(1, 0), cA + kstep, voffA); PG8_STAGE(PG8_SB(1, 1), cB + hstep + kstep, voffB);
        PG8_WAIT_V(6); PG8_BAR;
    }
    for (;;) {
        const bool has_next = S.next(ui + 1, nxt);
        const char* nA = has_next ? (const char*)(nxt.sel ? g.A1 : g.A0) + (size_t)nxt.pm * tstep : cA; const char* nB = has_next ? (const char*)(nxt.sel ? g.B1 : g.B0) + (size_t)nxt.pn * tstep : cB;
        for (int t = 0; t < nt; t += 2) {
            const bool last = (t == nt - 2);
            const char* a1 = cA + (size_t)(t + 1) * kstep;
            const char* a2 = last ? nA : cA + (size_t)(t + 2) * kstep; const char* b2 = last ? nB : cB + (size_t)(t + 2) * kstep;
            const char* a3 = a2 + kstep; const char* b3 = b2 + kstep;
            if constexpr (SP2) {
            PG8_LDB(B0, 0, 0); PG8_LDB(B1, 0, 1); PG8_SCHED; PG8_LDA(At, 0, 0); PG8_STAGE(PG8_SA(1, 1), a1 + hstep, voffA);
            PG8_WAIT_V(8); PG8_WAIT_L(0); PG8_BAR; PG8_MMA(0, 0, At, B0); PG8_MMA(0, 1, At, B1); PG8_BAR; PG8_SCHED;
            PG8_LDA(At, 0, 1); PG8_STAGE(PG8_SB(0, 0), b2, voffB); PG8_STAGE(PG8_SB(0, 1), b2 + hstep, voffB); PG8_STAGE(PG8_SA(0, 0), a2, voffA);
            PG8_WAIT_V(8); PG8_WAIT_L(0); PG8_BAR; PG8_MMA(1, 0, At, B0); PG8_MMA(1, 1, At, B1); PG8_BAR; PG8_SCHED;
            PG8_LDB(B0, 1, 0); PG8_LDB(B1, 1, 1); PG8_SCHED; PG8_LDA(At, 1, 0); PG8_STAGE(PG8_SA(0, 1), a2 + hstep, voffA);
            PG8_WAIT_V(8); PG8_WAIT_L(0); PG8_BAR; PG8_MMA(0, 0, At, B0); PG8_MMA(0, 1, At, B1); PG8_BAR; PG8_SCHED;
            PG8_LDA(At, 1, 1); PG8_STAGE(PG8_SB(1, 0), b3, voffB); PG8_STAGE(PG8_SB(1, 1), b3 + hstep, voffB); PG8_STAGE(PG8_SA(1, 0), a3, voffA);
            PG8_WAIT_V(8); PG8_WAIT_L(0); PG8_BAR; PG8_MMA(1, 0, At, B0); PG8_MMA(1, 1, At, B1); PG8_BAR; PG8_SCHED;
            } else {
            PG8_LDB(B0, 0, 0); PG8_SCHED; PG8_LDA(At, 0, 0); PG8_STAGE(PG8_SA(1, 1), a1 + hstep, voffA);
            PG8_WAIT_L(8); PG8_BAR; PG8_WAIT_L(0); PG8_MMA(0, 0, At, B0); PG8_BAR; PG8_SCHED;
            PG8_LDB(B1, 0, 1); PG8_STAGE(PG8_SB(0, 0), b2, voffB);
            PG8_BAR; PG8_WAIT_L(0); PG8_MMA(0, 1, At, B1); PG8_BAR;
            PG8_LDA(At, 0, 1); PG8_STAGE(PG8_SA(0, 0), a2, voffA);
            PG8_BAR; PG8_WAIT_L(0); PG8_MMA(1, 0, At, B0); PG8_BAR; PG8_SCHED;
            PG8_STAGE(PG8_SB(0, 1), b2 + hstep, voffB);
            PG8_WAIT_V(6); PG8_BAR; PG8_MMA(1, 1, At, B1); PG8_BAR;
            PG8_LDB(B0, 1, 0); PG8_SCHED; PG8_LDA(At, 1, 0); PG8_STAGE(PG8_SA(0, 1), a2 + hstep, voffA);
            PG8_WAIT_L(8); PG8_BAR; PG8_WAIT_L(0); PG8_MMA(0, 0, At, B0); PG8_BAR; PG8_SCHED;
            PG8_LDB(B1, 1, 1); PG8_STAGE(PG8_SB(1, 0), b3, voffB);
            PG8_BAR; PG8_WAIT_L(0); PG8_MMA(0, 1, At, B1); PG8_BAR;
            PG8_LDA(At, 1, 1); PG8_STAGE(PG8_SA(1, 0), a3, voffA);
            PG8_BAR; PG8_WAIT_L(0); PG8_MMA(1, 0, At, B0); PG8_BAR; PG8_SCHED;
            PG8_STAGE(PG8_SB(1, 1), b3 + hstep, voffB);
            PG8_WAIT_V(6); PG8_BAR; PG8_MMA(1, 1, At, B1); PG8_BAR;
            }
        }
        if constexpr (ALIGN_EPI) { if (wr == 0) PG8_BAR; }
        E(acc, cur, wr, wc, fr, fq);
        if (!has_next) break;
        if (!(Epi::PAIR && cur.sel == 0))
#pragma unroll
        for (int a = 0; a < 2; ++a)
#pragma unroll
            for (int b = 0; b < 2; ++b)
#pragma unroll
                for (int m = 0; m < 4; ++m)
#pragma unroll
                    for (int n = 0; n < 2; ++n) acc[a][b][m][n] = (f32x4){0.f, 0.f, 0.f, 0.f};
        cur = nxt; cA = nA; cB = nB; ++ui;
        if constexpr (ALIGN_EPI) { if (wr == 1) PG8_BAR; }
    }
    PG8_WAIT_V(0);
    if constexpr (!ALIGN_EPI) { if (wr == 0) PG8_BAR; }
    PG8_BAR;
#undef PG8_SA
#undef PG8_SB
#undef PG8_STAGE
#undef PG8_LDA
#undef PG8_LDB
#undef PG8_MMA
#undef PG8_WAIT_V
#undef PG8_WAIT_L
#undef PG8_BAR
#undef PG8_SCHED
}
}

#define LAS __attribute__((address_space(3)))
using pg8::bf16_t; using pg8::bf16x8; using pg8::f32x4; using pg8::u32x4; using pg8::u32x2; using pg8::cvt_pk_bf16; using pg8::bf_lo; using pg8::bf_hi;
constexpr int NB = 32, SEQ = 2048, DM = 1024, MTOK = NB * SEQ, NPROJ = 8192, NH = 16;
constexpr int NCHUNK = 2, MC = MTOK / NCHUNK, BPC = NB / NCHUNK;
static_assert(MC == pg8::PROJ_ROWS, "chunk rows");
constexpr float EPS = 1e-6f;
constexpr int NWAVES = 8, NTHREADS = 512, LDS_BYTES = 147456;
constexpr size_t MiB = 1u << 20;
constexpr size_t WS_MOD = 1 * MiB;
constexpr size_t WS_WIN = 2 * MiB;
constexpr size_t WS_WA = 18 * MiB, WS_WB = 20 * MiB, WS_WO = 22 * MiB;
constexpr size_t WS_H = 24 * MiB;
constexpr size_t WS_PROJ = 152 * MiB;
constexpr size_t WS_AG = 664 * MiB, WS_BG = 728 * MiB, WS_MG = 792 * MiB, WS_END = 856 * MiB;

__device__ __forceinline__ float wave_sum(float v) {
#pragma unroll
    for (int o = 1; o < 64; o <<= 1) v += __shfl_xor(v, o);
    return v;
}
__device__ __forceinline__ unsigned f2bf(float f) { unsigned u = __builtin_bit_cast(unsigned, f); return (u + 0x7fffu + ((u >> 16) & 1u)) >> 16; }
__device__ __forceinline__ unsigned pk2(float lo, float hi) { return f2bf(lo) | (f2bf(hi) << 16); }

__device__ __forceinline__ void p0_transpose_item(const float* W, int K, int N, bf16_t* WT, int row_off, LAS float* scr, int item, int lane) {
    const int nblk = N / 32, kb = item / nblk, nb = item % nblk, k0 = 64 * kb, n0 = 32 * nb;
#pragma unroll 8
    for (int i = 0; i < 32; ++i) { const int kk = 2 * i + (lane >> 5); scr[kk * 33 + (lane & 31)] = W[(size_t)(k0 + kk) * N + n0 + (lane & 31)]; }
    asm volatile("s_waitcnt lgkmcnt(0)" ::: "memory");
    const int c = lane & 7;
#pragma unroll
    for (int j = 0; j < 4; ++j) { const int n = (lane >> 3) + 8 * j; const LAS float* s = scr + (8 * c) * 33 + n;
        u32x4 o; o.x = pk2(s[0 * 33], s[1 * 33]); o.y = pk2(s[2 * 33], s[3 * 33]); o.z = pk2(s[4 * 33], s[5 * 33]); o.w = pk2(s[6 * 33], s[7 * 33]);
        *(u32x4*)(WT + (size_t)(row_off + n0 + n) * K + k0 + 8 * c) = o; }
    asm volatile("s_waitcnt lgkmcnt(0)" ::: "memory");
}

struct Args {
    const float* x; const float* c; const float* norm_gain; const float* w_ada; const float* b_ada; const float* w_in; const float* pool_w; const float* pool_scale;
    const float* w_a; const float* w_b; const float* w_out; const float* final_gain; float* out; unsigned char* ws;
};

__device__ __forceinline__ void p0_prologue(const Args& a, LAS unsigned char* lds, int tid, int lane, int wave) {
    const int blk = blockIdx.x;
    if (blk < 192) {
        LAS float* sc = (LAS float*)lds;
        for (int i = tid; i < NB * DM; i += NTHREADS) { const int b = i >> 10, k = i & 1023; const float v = a.c[i]; sc[k * 36 + b] = v * pg8::fast_sigmoid(v); }
        __syncthreads();
        const int kpart = tid >> 4, col = tid & 15, n = blk * 16 + col;
        float acc[32];
#pragma unroll
        for (int b = 0; b < 32; ++b) acc[b] = 0.f;
        for (int kk = 0; kk < 32; ++kk) { const int k = kpart * 32 + kk; const float w = a.w_ada[(size_t)k * 3072 + n];
#pragma unroll
            for (int b4 = 0; b4 < 8; ++b4) { const f32x4 s = *(const LAS f32x4*)(sc + k * 36 + 4 * b4); acc[4 * b4] += s[0] * w; acc[4 * b4 + 1] += s[1] * w; acc[4 * b4 + 2] += s[2] * w; acc[4 * b4 + 3] += s[3] * w; } }
        __syncthreads();
        LAS float* red = (LAS float*)lds;
#pragma unroll
        for (int b = 0; b < 32; ++b) red[(kpart * 32 + b) * 16 + col] = acc[b];
        __syncthreads();
        { const int b = tid >> 4; float s = 0.f;
            for (int kp = 0; kp < 32; ++kp) s += red[kp * 512 + tid];
            ((float*)(a.ws + WS_MOD))[(size_t)b * 3072 + n] = s + a.b_ada[n]; }
        __syncthreads();
    }
    for (int tile = blk; tile < 256; tile += gridDim.x) {
        const int g = tile >> 6, k0 = ((tile >> 2) & 15) * 64, n0 = (tile & 3) * 64;
        LAS float* As = (LAS float*)lds;
        LAS float* Bs = (LAS float*)(lds + 65792);
        for (int i = tid; i < 64 * 256; i += NTHREADS) { const int kk = i >> 8, j = i & 255; As[kk * 257 + j] = a.w_in[(size_t)(k0 + kk) * NPROJ + 4096 + g * 256 + j]; }
        for (int i = tid; i < 256 * 64; i += NTHREADS) { const int j = i >> 6, n = i & 63; Bs[j * 64 + n] = a.pool_w[((size_t)g * 256 + j) * 256 + n0 + n]; }
        __syncthreads();
        const int kk = tid >> 3, nn = (tid & 7) * 8;
        f32x4 c0 = {0.f, 0.f, 0.f, 0.f}, c1 = {0.f, 0.f, 0.f, 0.f};
#pragma unroll 4
        for (int j = 0; j < 256; ++j) { const float av = As[kk * 257 + j]; const f32x4 b0 = *(const LAS f32x4*)(Bs + j * 64 + nn), b1 = *(const LAS f32x4*)(Bs + j * 64 + nn + 4); c0 += b0 * av; c1 += b1 * av; }
        bf16_t* WT = (bf16_t*)(a.ws + WS_WIN) + (size_t)(4096 + g * 256 + n0 + nn) * 1024 + k0 + kk;
#pragma unroll
        for (int e = 0; e < 4; ++e) { WT[(size_t)e * 1024] = (bf16_t)f2bf(c0[e]); WT[(size_t)(e + 4) * 1024] = (bf16_t)f2bf(c1[e]); }
        __syncthreads();
    }
    {
        LAS float* scr = (LAS float*)(lds + wave * 16384);
        const int gw = blk * NWAVES + wave, NGW = gridDim.x * NWAVES;
        constexpr int I_IN = (DM / 64) * (NPROJ / 32), I_SQ = (DM / 64) * (DM / 32);
        for (int it = gw; it < I_IN + 3 * I_SQ; it += NGW) {
            int r = it;
            if (r < I_IN) { const int nb = r % (NPROJ / 32); if (nb < 128 || nb >= 160) p0_transpose_item(a.w_in, DM, NPROJ, (bf16_t*)(a.ws + WS_WIN), 0, scr, r, lane); continue; } r -= I_IN;
            if (r < I_SQ) { p0_transpose_item(a.w_a, DM, DM, (bf16_t*)(a.ws + WS_WA), 0, scr, r, lane); continue; } r -= I_SQ;
            if (r < I_SQ) { p0_transpose_item(a.w_b, DM, DM, (bf16_t*)(a.ws + WS_WB), 0, scr, r, lane); continue; } r -= I_SQ;
            p0_transpose_item(a.w_out, DM, DM, (bf16_t*)(a.ws + WS_WO), 0, scr, r, lane);
        }
    }
}

__device__ __forceinline__ void p1_prenorm(const Args& a, int lane, int wave) {
    const int gw = blockIdx.x * NWAVES + wave, NGW = gridDim.x * NWAVES;
    bf16_t* H = (bf16_t*)(a.ws + WS_H);
    for (int rb = gw; rb < MTOK / 32; rb += NGW) {
        const int b = rb >> 6; const float* mod = (const float*)(a.ws + WS_MOD) + (size_t)b * 3072;
        f32x4 ca[4], cs[4];
#pragma unroll
        for (int j = 0; j < 4; ++j) { const int c = 4 * lane + 256 * j; const f32x4 g = *(const f32x4*)(a.norm_gain + c), sc = *(const f32x4*)(mod + 1024 + c); ca[j] = g * (sc + 1.0f); cs[j] = *(const f32x4*)(mod + c); }
#pragma unroll 2
        for (int r = 0; r < 32; ++r) { const size_t row = (size_t)rb * 32 + r; const f32x4* xr = (const f32x4*)(a.x + row * DM) + lane;
            f32x4 v[4]; float s = 0.f;
#pragma unroll
            for (int j = 0; j < 4; ++j) { v[j] = xr[64 * j]; s += (v[j].x * v[j].x + v[j].y * v[j].y) + (v[j].z * v[j].z + v[j].w * v[j].w); }
            const float rstd = 1.0f / sqrtf(wave_sum(s) * (1.0f / DM) + EPS);
            u32x2* o8 = (u32x2*)(H + row * DM) + lane;
#pragma unroll
            for (int j = 0; j < 4; ++j) { const f32x4 o = v[j] * rstd * ca[j] + cs[j]; u32x2 w; w.x = cvt_pk_bf16(o.x, o.y); w.y = cvt_pk_bf16(o.z, o.w); o8[64 * j] = w; } }
    }
}
__device__ __forceinline__ void p6_final_norm(const Args& a, int lane, int wave) {
    const int gw = blockIdx.x * NWAVES + wave, NGW = gridDim.x * NWAVES;
    f32x4 fg[4];
#pragma unroll
    for (int j = 0; j < 4; ++j) fg[j] = *(const f32x4*)(a.final_gain + 4 * lane + 256 * j);
    for (int rb = gw; rb < MTOK / 32; rb += NGW) {
#pragma unroll 2
        for (int r = 0; r < 32; ++r) { const size_t row = (size_t)rb * 32 + r; f32x4* yr = (f32x4*)(a.out + row * DM) + lane;
            f32x4 v[4]; float s = 0.f;
#pragma unroll
            for (int j = 0; j < 4; ++j) { v[j] = yr[64 * j]; s += (v[j].x * v[j].x + v[j].y * v[j].y) + (v[j].z * v[j].z + v[j].w * v[j].w); }
            const float rstd = 1.0f / sqrtf(wave_sum(s) * (1.0f / DM) + EPS);
#pragma unroll
            for (int j = 0; j < 4; ++j) yr[64 * j] = v[j] * rstd * fg[j]; }
    }
}

__device__ __forceinline__ bf16x8 ldg8(const bf16_t* p) { return *(const bf16x8*)p; }
__device__ __forceinline__ void attn_unit(const bf16_t* __restrict__ Q, const bf16_t* __restrict__ K, const bf16_t* __restrict__ VT, const bf16_t* __restrict__ ZA, bf16_t* __restrict__ AG,
                                          int bl, int h, int qb, int lane) {
    const int ql = lane & 15, fq = lane >> 4, t0 = qb * 32;
    const size_t rowbase = (size_t)bl * SEQ;
    const bf16_t* Qp = Q + (rowbase + t0 + ql) * DM + h * 64 + 8 * fq;
    bf16x8 qf[2][2];
#pragma unroll
    for (int gq = 0; gq < 2; ++gq)
#pragma unroll
        for (int kh = 0; kh < 2; ++kh) qf[gq][kh] = ldg8(Qp + (size_t)gq * 16 * DM + kh * 32);
    const bf16_t* Kp = K + rowbase * DM + h * 64 + 8 * fq;
    const bf16_t* Vp = VT + ((size_t)bl * DM + h * 64 + ql) * SEQ;
    f32x4 o[4][2];
#pragma unroll
    for (int db = 0; db < 4; ++db) { o[db][0] = (f32x4){0.f, 0.f, 0.f, 0.f}; o[db][1] = (f32x4){0.f, 0.f, 0.f, 0.f}; }
    float rp[2] = {1.f, 1.f};
    const int kperm = 16 * (ql >> 2) + (ql & 3);
    constexpr float C2 = 0.125f * 1.4426950408889634f, THR = 7.8886090522101181e-31f;
    for (int jt = 0;; ++jt) {
        const int ks = t0 - 32 - 64 * jt;
        if (ks + 64 <= 0) break;
        bf16x8 kf[4][2], vf[4][2];
#pragma unroll
        for (int b = 0; b < 4; ++b) { int key = ks + kperm + 4 * b; key = key < 0 ? 0 : key;
#pragma unroll
            for (int kh = 0; kh < 2; ++kh) kf[b][kh] = ldg8(Kp + (size_t)key * DM + kh * 32); }
#pragma unroll
        for (int hv = 0; hv < 2; ++hv) { int key0 = ks + 16 * fq + 8 * hv; key0 = key0 < 0 ? 0 : key0;
#pragma unroll
            for (int db = 0; db < 4; ++db) vf[db][hv] = ldg8(Vp + (size_t)db * 16 * SEQ + key0); }
        f32x4 s[4][2];
#pragma unroll
        for (int b = 0; b < 4; ++b)
#pragma unroll
            for (int gq = 0; gq < 2; ++gq) { s[b][gq] = __builtin_amdgcn_mfma_f32_16x16x32_bf16(kf[b][0], qf[gq][0], (f32x4){0.f, 0.f, 0.f, 0.f}, 0, 0, 0);
                s[b][gq] = __builtin_amdgcn_mfma_f32_16x16x32_bf16(kf[b][1], qf[gq][1], s[b][gq], 0, 0, 0); }
        bf16x8 pf[2][2];
#pragma unroll
        for (int gq = 0; gq < 2; ++gq) {
            const int t = t0 + 16 * gq + ql;
            float om[16], be[16];
#pragma unroll
            for (int b = 0; b < 4; ++b)
#pragma unroll
                for (int i = 0; i < 4; ++i) { const int e = 4 * b + i, key = ks + 16 * fq + e; const bool valid = (key >= 0) && (key < t);
                    const float xs = fminf(s[b][gq][i] * C2, 60.f), ex = __builtin_amdgcn_exp2f(xs), omv = __builtin_amdgcn_rcpf(1.0f + ex);
                    om[e] = valid ? omv : 1.0f; be[e] = valid ? ex * omv : 0.0f; }
            float sp = 1.0f;
#pragma unroll
            for (int e = 15; e >= 0; --e) { const float tmp = om[e]; om[e] = sp; sp *= tmp; }
            const float T0 = __shfl(sp, ql), T1 = __shfl(sp, ql + 16), T2 = __shfl(sp, ql + 32), T3 = __shfl(sp, ql + 48);
            const float X = (fq < 1 ? T1 : 1.0f) * (fq < 2 ? T2 : 1.0f) * (fq < 3 ? T3 : 1.0f);
            const float f = X * rp[gq];
            rp[gq] *= (T0 * T1) * (T2 * T3);
            float w[16];
#pragma unroll
            for (int e = 0; e < 16; ++e) w[e] = be[e] * om[e] * f;
#pragma unroll
            for (int hv = 0; hv < 2; ++hv) { u32x4 pw; pw.x = cvt_pk_bf16(w[8 * hv], w[8 * hv + 1]); pw.y = cvt_pk_bf16(w[8 * hv + 2], w[8 * hv + 3]); pw.z = cvt_pk_bf16(w[8 * hv + 4], w[8 * hv + 5]); pw.w = cvt_pk_bf16(w[8 * hv + 6], w[8 * hv + 7]);
                pf[hv][gq] = __builtin_bit_cast(bf16x8, pw); }
        }
#pragma unroll
        for (int db = 0; db < 4; ++db)
#pragma unroll
            for (int gq = 0; gq < 2; ++gq) { o[db][gq] = __builtin_amdgcn_mfma_f32_16x16x32_bf16(vf[db][0], pf[0][gq], o[db][gq], 0, 0, 0);
                o[db][gq] = __builtin_amdgcn_mfma_f32_16x16x32_bf16(vf[db][1], pf[1][gq], o[db][gq], 0, 0, 0); }
        if (__all(fmaxf(rp[0], rp[1]) < THR)) break;
    }
#pragma unroll
    for (int gq = 0; gq < 2; ++gq)
#pragma unroll
        for (int db = 0; db < 4; ++db) { const size_t off = (rowbase + t0 + 16 * gq + ql) * DM + h * 64 + 16 * db + 4 * fq;
            const u32x2 z = *(const u32x2*)(ZA + off); const f32x4 ov = o[db][gq];
            u32x2 w; w.x = cvt_pk_bf16(ov[0] * bf_lo(z.x), ov[1] * bf_hi(z.x)); w.y = cvt_pk_bf16(ov[2] * bf_lo(z.y), ov[3] * bf_hi(z.y)); *(u32x2*)(AG + off) = w; }
}
__device__ __forceinline__ f32x4 ld4bf(const bf16_t* p) { const u32x2 w = *(const u32x2*)p; return (f32x4){bf_lo(w.x), bf_hi(w.x), bf_lo(w.y), bf_hi(w.y)}; }
__device__ __forceinline__ void pool_unit(const bf16_t* __restrict__ Y, const bf16_t* __restrict__ ZB, const float* __restrict__ pscale, bf16_t* __restrict__ BG, int bl, int g, int tb, int lane) {
    const int ch = g * 256 + lane * 4, win = 2 << g, t0 = tb * 32;
    const size_t base = (size_t)bl * SEQ * DM + ch;
    const f32x4 ps = *(const f32x4*)(pscale + ch);
    f32x4 run = {0.f, 0.f, 0.f, 0.f};
    for (int tt = t0 - win; tt < t0; ++tt) if (tt >= 0) run += ld4bf(Y + base + (size_t)tt * DM);
#pragma unroll 4
    for (int t = t0; t < t0 + 32; ++t) {
        const f32x4 yv = ld4bf(Y + base + (size_t)t * DM), zb = ld4bf(ZB + base + (size_t)t * DM);
        run += yv;
        if (t - win >= 0) run -= ld4bf(Y + base + (size_t)(t - win) * DM);
        const int cnt = (t + 1 < win) ? (t + 1) : win;
        const f32x4 d = run * (1.0f / (float)cnt) - yv, ov = d * ps * zb;
        u32x2 w; w.x = cvt_pk_bf16(ov[0], ov[1]); w.y = cvt_pk_bf16(ov[2], ov[3]); *(u32x2*)(BG + base + (size_t)t * DM) = w;
    }
}

__global__ void __launch_bounds__(NTHREADS) hybrid_fwd(Args a) {
    extern __shared__ __attribute__((aligned(16))) unsigned char lds_raw[];
    LAS unsigned char* lds = (LAS unsigned char*)lds_raw;
    cg::grid_group grid = cg::this_grid();
    const int tid = threadIdx.x, lane = tid & 63, wave = __builtin_amdgcn_readfirstlane(tid >> 6);
    const int G = gridDim.x;
    unsigned char* ws = a.ws;
    bf16_t* H = (bf16_t*)(ws + WS_H); bf16_t* PROJ = (bf16_t*)(ws + WS_PROJ);
    bf16_t* AGb = (bf16_t*)(ws + WS_AG); bf16_t* BGb = (bf16_t*)(ws + WS_BG); bf16_t* MG = (bf16_t*)(ws + WS_MG);
    const bf16_t* WIN = (const bf16_t*)(ws + WS_WIN); const bf16_t* WA = (const bf16_t*)(ws + WS_WA); const bf16_t* WB = (const bf16_t*)(ws + WS_WB); const bf16_t* WO = (const bf16_t*)(ws + WS_WO);

    p0_prologue(a, lds, tid, lane, wave);
    grid.sync();
    p1_prenorm(a, lane, wave);
    grid.sync();
    for (int ch = 0; ch < NCHUNK; ++ch) {
        { pg8::Gemm g{H + (size_t)ch * MC * DM, nullptr, WIN, nullptr, MC, NPROJ, DM}; pg8::StaticOrder S; S.init(MC, NPROJ, G, (int)blockIdx.x, 0);
          pg8::EpiProj E{PROJ}; pg8::gemm_phase<pg8::EpiProj, true, true>(lds, g, S, E); }
        grid.sync();
        { const int gw = blockIdx.x * NWAVES + wave, NGW = G * NWAVES;
          const bf16_t* Qb = PROJ; const bf16_t* Kb = PROJ + pg8::SEG_ELEMS; const bf16_t* VTb = PROJ + 2 * pg8::SEG_ELEMS; const bf16_t* ZAb = PROJ + 3 * pg8::SEG_ELEMS;
          const bf16_t* Yb = PROJ + 4 * pg8::SEG_ELEMS; const bf16_t* ZBb = PROJ + 5 * pg8::SEG_ELEMS;
          for (int U = gw; U < BPC * NH * 64; U += NGW) { const int bh = U >> 6, qb = U & 63; attn_unit(Qb, Kb, VTb, ZAb, AGb, bh >> 4, bh & 15, qb, lane); }
          for (int U = gw; U < BPC * 4 * 64; U += NGW) { pool_unit(Yb, ZBb, a.pool_scale, BGb, U >> 8, (U >> 6) & 3, U & 63, lane); } }
        grid.sync();
        { pg8::Gemm g{AGb, BGb, WA, WB, MC, DM, DM}; pg8::StaticOrder S; S.init(MC, DM, G, (int)blockIdx.x, 1);
          pg8::EpiMerge E{PROJ + 6 * pg8::SEG_ELEMS, PROJ + 7 * pg8::SEG_ELEMS, MG}; pg8::gemm_phase<pg8::EpiMerge, true, true>(lds, g, S, E); }
        grid.sync();
        { pg8::Gemm g{MG, nullptr, WO, nullptr, MC, DM, DM}; pg8::StaticOrder S; S.init(MC, DM, G, (int)blockIdx.x, 0);
          pg8::EpiOut E{a.x, (const float*)(ws + WS_MOD), a.out, ch * MC}; pg8::gemm_phase<pg8::EpiOut, true, true>(lds, g, S, E); }
    }
    grid.sync();
    p6_final_norm(a, lane, wave);
}

extern "C" void kernel_launch(void* const* d_in, const int* in_sizes, int n_in, void* d_out, int out_size, void* d_ws, size_t ws_size, hipStream_t stream) {
    static int grid = 0;
    if (grid == 0) {
        if (n_in != 12 || in_sizes[0] != MTOK * DM || out_size != MTOK * DM || ws_size < WS_END) { fprintf(stderr, "kernel_launch: unexpected shapes (n_in %d, in0 %d, out %d, ws %zu)\n", n_in, n_in > 0 ? in_sizes[0] : -1, out_size, ws_size); grid = -1; return; }
        int dev = 0, cus = 0, per_cu = 0;
        if (hipGetDevice(&dev) != hipSuccess || hipDeviceGetAttribute(&cus, hipDeviceAttributeMultiprocessorCount, dev) != hipSuccess) { grid = -1; return; }
        if (hipFuncSetAttribute((const void*)hybrid_fwd, hipFuncAttributeMaxDynamicSharedMemorySize, LDS_BYTES) != hipSuccess) { fprintf(stderr, "kernel_launch: hipFuncSetAttribute failed\n"); grid = -1; return; }
        if (hipOccupancyMaxActiveBlocksPerMultiprocessor(&per_cu, (const void*)hybrid_fwd, NTHREADS, LDS_BYTES) != hipSuccess || per_cu < 1) { fprintf(stderr, "kernel_launch: occupancy query says %d\n", per_cu); per_cu = 1; }
        (void)hipGetLastError();
        grid = cus;
    }
    if (grid < 0) return;
    Args a{};
    a.x = (const float*)d_in[0]; a.c = (const float*)d_in[1]; a.norm_gain = (const float*)d_in[2]; a.w_ada = (const float*)d_in[3]; a.b_ada = (const float*)d_in[4];
    a.w_in = (const float*)d_in[5]; a.pool_w = (const float*)d_in[6]; a.pool_scale = (const float*)d_in[7]; a.w_a = (const float*)d_in[8]; a.w_b = (const float*)d_in[9];
    a.w_out = (const float*)d_in[10]; a.final_gain = (const float*)d_in[11]; a.out = (float*)d_out; a.ws = (unsigned char*)d_ws;
    void* args[] = {&a};
    hipError_t e = hipLaunchCooperativeKernel((const void*)hybrid_fwd, dim3(grid), dim3(NTHREADS), args, LDS_BYTES, stream);
    if (e != hipSuccess) fprintf(stderr, "kernel_launch: cooperative launch failed: %s (grid %d)\n", hipGetErrorString(e), grid);
}
```

```cpp
#include <hip/hip_runtime.h>
#include <hip/hip_cooperative_groups.h>
#include <cstdio>
#include <cstdint>
namespace cg = cooperative_groups;

namespace pg8 {
#define PG8_LAS __attribute__((address_space(3)))
typedef unsigned short bf16_t;
typedef short bf16x8 __attribute__((ext_vector_type(8)));
typedef float f32x4 __attribute__((ext_vector_type(4)));
typedef unsigned u32x4 __attribute__((ext_vector_type(4)));
typedef unsigned u32x2 __attribute__((ext_vector_type(2)));
constexpr int BM = 256, BK = 64, HALF = 128, HTB = HALF * BK * 2  , STAGE_BYTES = 8 * HTB, NXCD = 8, WGM = 8;

__host__ __device__ __forceinline__ int lds_byte(int r, int c) { const int st = (r >> 4) * 2 + (c >> 5), rr = r & 15, cc = c & 31, ob = rr * 64 + cc * 2; return st * 1024 + (ob ^ (((ob >> 9) & 1) << 5)); }
__host__ __device__ __forceinline__ void stage_rc(int b, int& R, int& C) { const int st = b / 1024, sb = b % 1024, swz = sb ^ (((sb >> 9) & 1) << 5); R = (st >> 1) * 16 + swz / 64; C = (st & 1) * 32 + (swz % 64) / 2; }
__host__ __device__ __forceinline__ int perm32(int rho) { const int n = rho >> 4, i = rho & 15; return 8 * (i >> 2) + 4 * n + (i & 3); }

struct Unit { int pm, pn, sel; };
struct Gemm { const bf16_t* A0; const bf16_t* A1; const bf16_t* B0; const bf16_t* B1; int M, N, K; };

struct StaticOrder {
    int nM, nN, nwg, G, c, pair;
    __host__ __device__ void init(int M, int N, int G_, int c_, int pair_) { nM = M / BM; nN = N / BM; nwg = nM * nN; G = G_; c = c_; pair = pair_; }
    __host__ __device__ bool next(int ii, Unit& u) const {
        const int i = pair ? (ii >> 1) : ii; u.sel = pair ? (ii & 1) : 0;
        const long L = (long)i * G + c; if (L >= nwg) return false;
        int wgid = (int)L; { const int q = nwg / NXCD, r = nwg % NXCD, xcd = wgid % NXCD, off = wgid / NXCD; wgid = (xcd < r ? xcd * (q + 1) : r * (q + 1) + (xcd - r) * q) + off; }
        const int nig = WGM * nN, gid = wgid / nig, fm = gid * WGM, gsz = (nM - fm) < WGM ? (nM - fm) : WGM;
        u.pm = fm + ((wgid % nig) % gsz); u.pn = (wgid % nig) / gsz; return true;
    }
};

__device__ __forceinline__ unsigned cvt_pk_bf16(float lo, float hi) { unsigned r; asm("v_cvt_pk_bf16_f32 %0, %1, %2" : "=v"(r) : "v"(lo), "v"(hi)); return r; }
__device__ __forceinline__ float bf_lo(unsigned w) { return __uint_as_float(w << 16); }
__device__ __forceinline__ float bf_hi(unsigned w) { return __uint_as_float(w & 0xffff0000u); }
__device__ __forceinline__ float fast_sigmoid(float x) { return __builtin_amdgcn_rcpf(1.0f + __expf(-x)); }

constexpr int PROJ_ROWS = 32768;
constexpr size_t SEG_ELEMS = (size_t)PROJ_ROWS * 1024;
struct EpiProj {
    static constexpr bool PERM = true, PAIR = false;
    bf16_t* P;
    __device__ __forceinline__ void operator()(f32x4 (&acc)[2][2][4][2], const Unit& u, int wr, int wc, int fr, int fq) const {
        const int sg = u.pn >> 2, colt = (u.pn & 3) * BM;
        const int row0 = u.pm * BM + wr * 64 + fr, col0 = colt + wc * 32 + 8 * fq;
        bf16_t* base = P + (size_t)sg * SEG_ELEMS;
        if (sg == 2) {
#pragma unroll
            for (int ai = 0; ai < 2; ++ai)
#pragma unroll
                for (int m = 0; m < 4; ++m) { const int r = row0 + ai * HALF + m * 16; bf16_t* vp = base + ((size_t)(r >> 11) * 1024 + col0) * 2048 + (r & 2047);
#pragma unroll
                    for (int bj = 0; bj < 2; ++bj)
#pragma unroll
                        for (int n = 0; n < 2; ++n)
#pragma unroll
                            for (int j = 0; j < 4; ++j) { const float v = acc[ai][bj][m][n][j]; vp[(size_t)(bj * HALF + 4 * n + j) * 2048] = (bf16_t)(cvt_pk_bf16(v, v) & 0xffffu); } }
        } else {
            const int act = (sg == 3 || sg == 5) ? 1 : (sg >= 6 ? 2 : 0);
#pragma unroll
            for (int ai = 0; ai < 2; ++ai)
#pragma unroll
                for (int m = 0; m < 4; ++m) { bf16_t* rowp = base + (size_t)(row0 + ai * HALF + m * 16) * 1024 + col0;
#pragma unroll
                    for (int bj = 0; bj < 2; ++bj) { f32x4 v0 = acc[ai][bj][m][0], v1 = acc[ai][bj][m][1];
                        if (act) {
#pragma unroll
                            for (int j = 0; j < 4; ++j) { const float s0 = fast_sigmoid(v0[j]), s1 = fast_sigmoid(v1[j]); v0[j] = (act == 1) ? v0[j] * s0 : s0; v1[j] = (act == 1) ? v1[j] * s1 : s1; } }
                        u32x4 w; w.x = cvt_pk_bf16(v0[0], v0[1]); w.y = cvt_pk_bf16(v0[2], v0[3]); w.z = cvt_pk_bf16(v1[0], v1[1]); w.w = cvt_pk_bf16(v1[2], v1[3]);
                        *(u32x4*)(rowp + bj * HALF) = w; } }
        }
    }
};
struct EpiMerge {
    static constexpr bool PERM = true, PAIR = true;
    const bf16_t* SA; const bf16_t* SB; bf16_t* O;
    __device__ __forceinline__ void operator()(f32x4 (&acc)[2][2][4][2], const Unit& u, int wr, int wc, int fr, int fq) const {
        const int row0 = u.pm * BM + wr * 64 + fr, col0 = u.pn * BM + wc * 32 + 8 * fq;
#pragma unroll
        for (int ai = 0; ai < 2; ++ai)
#pragma unroll
            for (int m = 0; m < 4; ++m) { const size_t off = (size_t)(row0 + ai * HALF + m * 16) * 1024 + col0;
#pragma unroll
                for (int bj = 0; bj < 2; ++bj) {
                    const u32x4 sbw = *(const u32x4*)(SB + off + bj * HALF);
                    float sb[8];
#pragma unroll
                    for (int j = 0; j < 4; ++j) { sb[2 * j] = fmaxf(bf_lo(sbw[j]), 1e-30f); sb[2 * j + 1] = fmaxf(bf_hi(sbw[j]), 1e-30f); }
                    if (u.sel == 0) {
                        const u32x4 saw = *(const u32x4*)(SA + off + bj * HALF);
#pragma unroll
                        for (int j = 0; j < 4; ++j) { const float r0 = bf_lo(saw[j]) * __builtin_amdgcn_rcpf(sb[2 * j]), r1 = bf_hi(saw[j]) * __builtin_amdgcn_rcpf(sb[2 * j + 1]);
                            if (j < 2) { acc[ai][bj][m][0][2 * j] *= r0; acc[ai][bj][m][0][2 * j + 1] *= r1; } else { acc[ai][bj][m][1][2 * j - 4] *= r0; acc[ai][bj][m][1][2 * j - 3] *= r1; } }
                    } else {
                        const f32x4 v0 = acc[ai][bj][m][0], v1 = acc[ai][bj][m][1];
                        u32x4 w; w.x = cvt_pk_bf16(v0[0] * sb[0], v0[1] * sb[1]); w.y = cvt_pk_bf16(v0[2] * sb[2], v0[3] * sb[3]); w.z = cvt_pk_bf16(v1[0] * sb[4], v1[1] * sb[5]); w.w = cvt_pk_bf16(v1[2] * sb[6], v1[3] * sb[7]);
                        *(u32x4*)(O + off + bj * HALF) = w; } } }
    }
};
struct EpiOut {
    static constexpr bool PERM = false, PAIR = false;
    const float* x; const float* mod; float* out; int row_off;
    __device__ __forceinline__ void operator()(f32x4 (&acc)[2][2][4][2], const Unit& u, int wr, int wc, int fr, int fq) const {
        const int R0 = row_off + u.pm * BM + wr * 64 + fr, col0 = u.pn * BM + wc * 32 + 4 * fq;
        const float* gate = mod + (size_t)((row_off + u.pm * BM) >> 11) * 3072 + 2048;
        f32x4 gv[2][2];
#pragma unroll
        for (int bj = 0; bj < 2; ++bj)
#pragma unroll
            for (int n = 0; n < 2; ++n) gv[bj][n] = *(const f32x4*)(gate + col0 + bj * HALF + n * 16);
#pragma unroll
        for (int ai = 0; ai < 2; ++ai)
#pragma unroll
            for (int m = 0; m < 4; ++m) { const size_t off = (size_t)(R0 + ai * HALF + m * 16) * 1024 + col0;
#pragma unroll
                for (int bj = 0; bj < 2; ++bj)
#pragma unroll
                    for (int n = 0; n < 2; ++n) { const f32x4 xv = *(const f32x4*)(x + off + bj * HALF + n * 16); *(f32x4*)(out + off + bj * HALF + n * 16) = xv + gv[bj][n] * acc[ai][bj][m][n]; } }
    }
};

template <class Epi, bool ALIGN_EPI, bool SP2>
__device__ __forceinline__ void gemm_phase(PG8_LAS unsigned char* lds, const Gemm g, const StaticOrder& S, const Epi& E) {
    int tid_l = threadIdx.x; asm volatile("" : "+v"(tid_l));
    const int tid = tid_l, wid = __builtin_amdgcn_readfirstlane(tid >> 6), lane = tid & 63, wr = wid >> 2, wc = wid & 3, fr = lane & 15, fq = lane >> 4;
    const int K = g.K, nt = K / BK;
    unsigned voffA[2], voffB[2];
#pragma unroll
    for (int i = 0; i < 2; ++i) { int R, C; stage_rc(tid * 16 + i * 8192, R, C); const int Rb = Epi::PERM ? ((R & ~31) + perm32(R & 31)) : R;
        voffA[i] = (unsigned)(R * K + C) * 2u; voffB[i] = (unsigned)(Rb * K + C) * 2u; }
    const size_t kstep = (size_t)(BK * 2);
    const size_t hstep = (size_t)HALF * K * 2;
    const size_t tstep = 2 * hstep;
    const unsigned ldsw = (unsigned)wid * 1024u;
    const int aoff = lds_byte(wr * 64 + fr, fq * 8), boff = lds_byte(wc * 32 + fr, fq * 8);
#define PG8_SA(b, h) (((b) * 2 + (h)) * HTB)
#define PG8_SB(b, h) ((4 + (b) * 2 + (h)) * HTB)
#define PG8_STAGE(bufoff, gbase, voff) do { _Pragma("unroll") for (int _i = 0; _i < 2; ++_i) \
        __builtin_amdgcn_global_load_lds((const unsigned*)((const char*)(gbase) + (voff)[_i]), (PG8_LAS unsigned*)(lds + (bufoff) + ldsw + _i * 8192), 16, 0, 0); } while (0)
#define PG8_LDA(dst, b, h) do { _Pragma("unroll") for (int m = 0; m < 4; ++m) _Pragma("unroll") for (int k = 0; k < 2; ++k) dst[m][k] = *(const PG8_LAS bf16x8*)(lds + PG8_SA(b, h) + aoff + m * 2048 + k * 1024); } while (0)
#define PG8_LDB(dst, b, h) do { _Pragma("unroll") for (int n = 0; n < 2; ++n) _Pragma("unroll") for (int k = 0; k < 2; ++k) dst[n][k] = *(const PG8_LAS bf16x8*)(lds + PG8_SB(b, h) + boff + n * 2048 + k * 1024); } while (0)
#define PG8_MMA(ai, bj, At, Bt) do { __builtin_amdgcn_s_setprio(1); _Pragma("unroll") for (int m = 0; m < 4; ++m) _Pragma("unroll") for (int n = 0; n < 2; ++n) _Pragma("unroll") for (int k = 0; k < 2; ++k) \
        acc[ai][bj][m][n] = __builtin_amdgcn_mfma_f32_16x16x32_bf16(Bt[n][k], At[m][k], acc[ai][bj][m][n], 0, 0, 0); __builtin_amdgcn_s_setprio(0); } while (0)
#define PG8_WAIT_V(n) asm volatile("s_waitcnt vmcnt(" #n ")" ::: "memory")
#define PG8_WAIT_L(n) asm volatile("s_waitcnt lgkmcnt(" #n ")" ::: "memory")
#define PG8_BAR __builtin_amdgcn_s_barrier()
#define PG8_SCHED __builtin_amdgcn_sched_barrier(0)
    Unit cur, nxt; int ui = 0;
    if (!S.next(0, cur)) return;
    f32x4 acc[2][2][4][2];
#pragma unroll
    for (int a = 0; a < 2; ++a)
#pragma unroll
        for (int b = 0; b < 2; ++b)
#pragma unroll
            for (int m = 0; m < 4; ++m)
#pragma unroll
                for (int n = 0; n < 2; ++n) acc[a][b][m][n] = (f32x4){0.f, 0.f, 0.f, 0.f};
    bf16x8 At[4][2], B0[2][2], B1[2][2];
    const char* cA = (const char*)(cur.sel ? g.A1 : g.A0) + (size_t)cur.pm * tstep; const char* cB = (const char*)(cur.sel ? g.B1 : g.B0) + (size_t)cur.pn * tstep;
    if constexpr (SP2) {
        PG8_STAGE(PG8_SB(0, 0), cB, voffB); PG8_STAGE(PG8_SB(0, 1), cB + hstep, voffB); PG8_STAGE(PG8_SA(0, 0), cA, voffA); PG8_STAGE(PG8_SA(0, 1), cA + hstep, voffA);
        if (wr == 1) PG8_BAR;
        PG8_WAIT_V(2); PG8_BAR;
        PG8_STAGE(PG8_SB(1, 0), cB + kstep, voffB); PG8_STAGE(PG8_SA(1, 0), cA + kstep, voffA); PG8_STAGE(PG8_SB(1, 1), cB + hstep + kstep, voffB);
        PG8_WAIT_V(6); PG8_BAR;
    } else {
        PG8_STAGE(PG8_SB(0, 0), cB, voffB); PG8_STAGE(PG8_SA(0, 0), cA, voffA); PG8_STAGE(PG8_SB(0, 1), cB + hstep, voffB); PG8_STAGE(PG8_SA(0, 1), cA + hstep, voffA);
        if (wr == 1) PG8_BAR;
        PG8_WAIT_V(4); PG8_BAR;
        PG8_STAGE(PG8_SB(1, 0), cB + kstep, voffB); PG8_STAGE(PG8_SA(1, 0), cA + kstep, voffA); PG8_STAGE(PG8_SB(1, 1), cB + hstep + kstep, voffB);
        PG8_WAIT_V(6); PG8_BAR;
    }
    for (;;) {
        const bool has_next = S.next(ui + 1, nxt);
        const char* nA = has_next ? (const char*)(nxt.sel ? g.A1 : g.A0) + (size_t)nxt.pm * tstep : cA; const char* nB = has_next ? (const char*)(nxt.sel ? g.B1 : g.B0) + (size_t)nxt.pn * tstep : cB;
        for (int t = 0; t < nt; t += 2) {
            const bool last = (t == nt - 2);
            const char* a1 = cA + (size_t)(t + 1) * kstep;
            const char* a2 = last ? nA : cA + (size_t)(t + 2) * kstep; const char* b2 = last ? nB : cB + (size_t)(t + 2) * kstep;
            const char* a3 = a2 + kstep; const char* b3 = b2 + kstep;
            if constexpr (SP2) {
            PG8_LDB(B0, 0, 0); PG8_LDB(B1, 0, 1); PG8_SCHED; PG8_LDA(At, 0, 0); PG8_STAGE(PG8_SA(1, 1), a1 + hstep, voffA);
            PG8_WAIT_V(8); PG8_WAIT_L(0); PG8_BAR; PG8_MMA(0, 0, At, B0); PG8_MMA(0, 1, At, B1); PG8_BAR; PG8_SCHED;
            PG8_LDA(At, 0, 1); PG8_STAGE(PG8_SB(0, 0), b2, voffB); PG8_STAGE(PG8_SB(0, 1), b2 + hstep, voffB); PG8_STAGE(PG8_SA(0, 0), a2, voffA);
            PG8_WAIT_V(8); PG8_WAIT_L(0); PG8_BAR; PG8_MMA(1, 0, At, B0); PG8_MMA(1, 1, At, B1); PG8_BAR; PG8_SCHED;
            PG8_LDB(B0, 1, 0); PG8_LDB(B1, 1, 1); PG8_SCHED; PG8_LDA(At, 1, 0); PG8_STAGE(PG8_SA(0, 1), a2 + hstep, voffA);
            PG8_WAIT_V(8); PG8_WAIT_L(0); PG8_BAR; PG8_MMA(0, 0, At, B0); PG8_MMA(0, 1, At, B1); PG8_BAR; PG8_SCHED;
            PG8_LDA(At, 1, 1); PG8_STAGE(PG8_SB(1, 0), b3, voffB); PG8_STAGE(PG8_SB(1, 1), b3 + hstep, voffB); PG8_STAGE(PG8_SA(1, 0), a3, voffA);
            PG8_WAIT_V(8); PG8_WAIT_L(0); PG8_BAR; PG8_MMA(1, 0, At, B0); PG8_MMA(1, 1, At, B1); PG8_BAR; PG8_SCHED;
            } else {
            PG8_LDB(B0, 0, 0); PG8_SCHED; PG8_LDA(At, 0, 0); PG8_STAGE(PG8_SA(1, 1), a1 + hstep, voffA);
            PG8_WAIT_L(8); PG8_BAR; PG8_WAIT_L(0); PG8_MMA(0, 0, At, B0); PG8_BAR; PG8_SCHED;
            PG8_LDB(B1, 0, 1); PG8_STAGE(PG8_SB(0, 0), b2, voffB);
            PG8_BAR; PG8_WAIT_L(0); PG8_MMA(0, 1, At, B1); PG8_BAR;
            PG8_LDA(At, 0, 1); PG8_STAGE(PG8_SA(0, 0), a2, voffA);
            PG8_BAR; PG8_WAIT_L(0); PG8_MMA(1, 0, At, B0); PG8_BAR; PG8_SCHED;
            PG8_STAGE(PG8_SB(0, 1), b2 + hstep, voffB);
            PG8_WAIT_V(6); PG8_BAR; PG8_MMA(1, 1, At, B1); PG8_BAR;
            PG8_LDB(B0, 1, 0); PG8_SCHED; PG8_LDA(At, 1, 0); PG8_STAGE(PG8_SA(0, 1), a2 + hstep, voffA);
            PG8_WAIT_L(8); PG8_BAR; PG8_WAIT_L(0); PG8_MMA(0, 0, At, B0); PG8_BAR; PG8_SCHED;
            PG8_LDB(B1, 1, 1); PG8_STAGE(PG8_SB(1, 0), b3, voffB);
            PG8_BAR; PG8_WAIT_L(0); PG8_MMA(0, 1, At, B1); PG8_BAR;
            PG8_LDA(At, 1, 1); PG8_STAGE(PG8_SA(1, 0), a3, voffA);
            PG8_BAR; PG8_WAIT_L(0); PG8_MMA(1, 0, At, B0); PG8_BAR; PG8_SCHED;
            PG8_STAGE(PG8_SB(1, 1), b3 + hstep, voffB);
            PG8_WAIT_V(6); PG8_BAR; PG8_MMA(1, 1, At, B1); PG8_BAR;
            }
        }
        if constexpr (ALIGN_EPI) { if (wr == 0) PG8_BAR; }
        E(acc, cur, wr, wc, fr, fq);
        if (!has_next) break;
        if (!(Epi::PAIR && cur.sel == 0))
#pragma unroll
        for (int a = 0; a < 2; ++a)
#pragma unroll
            for (int b = 0; b < 2; ++b)
#pragma unroll
                for (int m = 0; m < 4; ++m)
#pragma unroll
                    for (int n = 0; n < 2; ++n) acc[a][b][m][n] = (f32x4){0.f, 0.f, 0.f, 0.f};
        cur = nxt; cA = nA; cB = nB; ++ui;
        if constexpr (ALIGN_EPI) { if (wr == 1) PG8_BAR; }
    }
    PG8_WAIT_V(0);
    if constexpr (!ALIGN_EPI) { if (wr == 0) PG8_BAR; }
    PG8_BAR;
#undef PG8_SA
#undef PG8_SB
#undef PG8_STAGE
#undef PG8_LDA
#undef PG8_LDB
#undef PG8_MMA
#undef PG8_WAIT_V
#undef PG8_WAIT_L
#undef PG8_BAR
#undef PG8_SCHED
}
}

#define LAS __attribute__((address_space(3)))
using pg8::bf16_t; using pg8::bf16x8; using pg8::f32x4; using pg8::u32x4; using pg8::u32x2; using pg8::cvt_pk_bf16; using pg8::bf_lo; using pg8::bf_hi;
constexpr int NB = 32, SEQ = 2048, DM = 1024, MTOK = NB * SEQ, NPROJ = 8192, NH = 16;
constexpr int NCHUNK = 2, MC = MTOK / NCHUNK, BPC = NB / NCHUNK;
static_assert(MC == pg8::PROJ_ROWS, "chunk rows");
constexpr float EPS = 1e-6f;
constexpr int NWAVES = 8, NTHREADS = 512, MISC_OFF = 147456, LDS_BYTES = MISC_OFF + 256;
constexpr size_t MiB = 1u << 20;
constexpr size_t WS_MOD = 1 * MiB;
constexpr size_t WS_WIN = 2 * MiB;
constexpr size_t WS_WA = 18 * MiB, WS_WB = 20 * MiB, WS_WO = 22 * MiB;
constexpr size_t WS_H = 24 * MiB;
constexpr size_t WS_PROJ = 152 * MiB;
constexpr size_t WS_AG = 664 * MiB, WS_BG = 728 * MiB, WS_MG = 792 * MiB, WS_END = 856 * MiB;

__device__ __forceinline__ float wave_sum(float v) {
#pragma unroll
    for (int o = 1; o < 64; o <<= 1) v += __shfl_xor(v, o);
    return v;
}
__device__ __forceinline__ unsigned f2bf(float f) { unsigned u = __builtin_bit_cast(unsigned, f); return (u + 0x7fffu + ((u >> 16) & 1u)) >> 16; }
__device__ __forceinline__ unsigned pk2(float lo, float hi) { return f2bf(lo) | (f2bf(hi) << 16); }

__device__ __forceinline__ void p0_transpose_item(const float* W, int K, int N, bf16_t* WT, int row_off, LAS float* scr, int item, int lane) {
    const int nblk = N / 32, kb = item / nblk, nb = item % nblk, k0 = 64 * kb, n0 = 32 * nb;
#pragma unroll 8
    for (int i = 0; i < 32; ++i) { const int kk = 2 * i + (lane >> 5); scr[kk * 33 + (lane & 31)] = W[(size_t)(k0 + kk) * N + n0 + (lane & 31)]; }
    asm volatile("s_waitcnt lgkmcnt(0)" ::: "memory");
    const int c = lane & 7;
#pragma unroll
    for (int j = 0; j < 4; ++j) { const int n = (lane >> 3) + 8 * j; const LAS float* s = scr + (8 * c) * 33 + n;
        u32x4 o; o.x = pk2(s[0 * 33], s[1 * 33]); o.y = pk2(s[2 * 33], s[3 * 33]); o.z = pk2(s[4 * 33], s[5 * 33]); o.w = pk2(s[6 * 33], s[7 * 33]);
        *(u32x4*)(WT + (size_t)(row_off + n0 + n) * K + k0 + 8 * c) = o; }
    asm volatile("s_waitcnt lgkmcnt(0)" ::: "memory");
}

#define XB_TMO      128
#define XB_XCNT(j)  (256  + 64 * (j))
#define XB_XSUB(j)  (1280 + 64 * (j))
#define XB_XGEN(j)  (2304 + 64 * (j))
#define XB_TOP      3328
#define XB_TOPGEN   3392
#define XCD_BAR_WORDS 3456
#define XB_SPIN_CAP (1u << 18)

__device__ __forceinline__ unsigned xb_ld(unsigned* p)              { return __hip_atomic_load(p, __ATOMIC_RELAXED, __HIP_MEMORY_SCOPE_AGENT); }
__device__ __forceinline__ unsigned xb_add(unsigned* p, unsigned v) { return __hip_atomic_fetch_add(p, v, __ATOMIC_RELAXED, __HIP_MEMORY_SCOPE_AGENT); }
__device__ __forceinline__ unsigned xb_xcc_id() { return (unsigned)__builtin_amdgcn_s_getreg((3 << 11) | 20) & 0xFu; }
#define XB_SPIN(cond, bar) do { unsigned _sp = 0; while (cond) { __builtin_amdgcn_s_sleep(1); \
    if ((++_sp & 255u) == 0u) { if (xb_ld(&(bar)[XB_TMO])) break; if (_sp > XB_SPIN_CAP) { atomicAdd(&(bar)[XB_TMO], 1u); break; } } } } while (0)

struct XcdBarrier {
    unsigned* bar; unsigned x;
    volatile LAS unsigned* st;
};

__device__ __forceinline__ XcdBarrier xcd_barrier_post(unsigned* bar, volatile LAS unsigned* st) {
    XcdBarrier b; b.bar = bar; b.x = xb_xcc_id(); b.st = st;
    if (threadIdx.x == 0) (void)xb_add(&bar[XB_XCNT(b.x)], 1u);
    return b;
}
__device__ __forceinline__ void xcd_barrier_complete(unsigned* bar, unsigned x, unsigned& nloc, unsigned& nx) {
    const unsigned G = gridDim.x * gridDim.y * gridDim.z;
    unsigned sum, cnt, mine, sp = 0u;
    for (;;) {
        sum = 0u; cnt = 0u; mine = 0u;
#pragma unroll
        for (unsigned j = 0; j < 16; ++j) { const unsigned c = xb_ld(&bar[XB_XCNT(j)]); sum += c; cnt += (c > 0u) ? 1u : 0u; mine = (j == x) ? c : mine; }
        if (sum == G) break;
        __builtin_amdgcn_s_sleep(1);
        if ((++sp & 255u) == 0u) { if (xb_ld(&bar[XB_TMO])) break; if (sp > XB_SPIN_CAP) { atomicAdd(&bar[XB_TMO], 1u); break; } }
    }
    nloc = mine > 0u ? mine : 1u; nx = cnt > 0u ? cnt : 1u;
}

__device__ __forceinline__ void xcd_barrier(const XcdBarrier& b) {
    asm volatile("s_waitcnt vmcnt(0)" ::: "memory");
    __syncthreads();
    if (threadIdx.x == 0) {
        unsigned* bar = b.bar;
        __builtin_amdgcn_s_waitcnt(0);
        unsigned nloc = b.st[0], nx = b.st[1];
        if (nloc == 0u) { xcd_barrier_complete(bar, b.x, nloc, nx); b.st[0] = nloc; b.st[1] = nx; }
        const unsigned old = xb_add(&bar[XB_XSUB(b.x)], 1u);
        const unsigned gen = old / nloc;
        if (old + 1u == (gen + 1u) * nloc) {
            __builtin_amdgcn_fence(__ATOMIC_RELEASE, "agent");
            asm volatile("s_waitcnt vmcnt(0)" ::: "memory");
            const unsigned og = xb_add(&bar[XB_TOP], 1u);
            const unsigned tg = og / nx;
            if (og + 1u == (tg + 1u) * nx) xb_add(&bar[XB_TOPGEN], 1u);
            else XB_SPIN(xb_ld(&bar[XB_TOPGEN]) == tg, bar);
            __builtin_amdgcn_fence(__ATOMIC_ACQUIRE, "agent");
            xb_add(&bar[XB_XGEN(b.x)], 1u);
            asm volatile("s_waitcnt vmcnt(0)" ::: "memory");
        } else {
            XB_SPIN(xb_ld(&bar[XB_XGEN(b.x)]) == gen, bar);
            __builtin_amdgcn_fence(__ATOMIC_ACQUIRE, "agent");
            asm volatile("s_waitcnt vmcnt(0)" ::: "memory");
        }
    }
    __syncthreads();
}

struct Args {
    const float* x; const float* c; const float* norm_gain; const float* w_ada; const float* b_ada; const float* w_in; const float* pool_w; const float* pool_scale;
    const float* w_a; const float* w_b; const float* w_out; const float* final_gain; float* out; unsigned char* ws;
};

__device__ __forceinline__ void p0_prologue(const Args& a, LAS unsigned char* lds, int tid, int lane, int wave) {
    const int blk = blockIdx.x;
    if (blk < 192) {
        LAS float* sc = (LAS float*)lds;
        for (int i = tid; i < NB * DM; i += NTHREADS) { const int b = i >> 10, k = i & 1023; const float v = a.c[i]; sc[k * 36 + b] = v * pg8::fast_sigmoid(v); }
        __syncthreads();
        const int kpart = tid >> 4, col = tid & 15, n = blk * 16 + col;
        float acc[32];
#pragma unroll
        for (int b = 0; b < 32; ++b) acc[b] = 0.f;
        for (int kk = 0; kk < 32; ++kk) { const int k = kpart * 32 + kk; const float w = a.w_ada[(size_t)k * 3072 + n];
#pragma unroll
            for (int b4 = 0; b4 < 8; ++b4) { const f32x4 s = *(const LAS f32x4*)(sc + k * 36 + 4 * b4); acc[4 * b4] += s[0] * w; acc[4 * b4 + 1] += s[1] * w; acc[4 * b4 + 2] += s[2] * w; acc[4 * b4 + 3] += s[3] * w; } }
        __syncthreads();
        LAS float* red = (LAS float*)lds;
#pragma unroll
        for (int b = 0; b < 32; ++b) red[(kpart * 32 + b) * 16 + col] = acc[b];
        __syncthreads();
        { const int b = tid >> 4; float s = 0.f;
            for (int kp = 0; kp < 32; ++kp) s += red[kp * 512 + tid];
            ((float*)(a.ws + WS_MOD))[(size_t)b * 3072 + n] = s + a.b_ada[n]; }
        __syncthreads();
    }
    for (int tile = blk; tile < 256; tile += gridDim.x) {
        const int g = tile >> 6, k0 = ((tile >> 2) & 15) * 64, n0 = (tile & 3) * 64;
        LAS float* As = (LAS float*)lds;
        LAS float* Bs = (LAS float*)(lds + 65792);
        for (int i = tid; i < 64 * 256; i += NTHREADS) { const int kk = i >> 8, j = i & 255; As[kk * 257 + j] = a.w_in[(size_t)(k0 + kk) * NPROJ + 4096 + g * 256 + j]; }
        for (int i = tid; i < 256 * 64; i += NTHREADS) { const int j = i >> 6, n = i & 63; Bs[j * 64 + n] = a.pool_w[((size_t)g * 256 + j) * 256 + n0 + n]; }
        __syncthreads();
        const int kk = tid >> 3, nn = (tid & 7) * 8;
        f32x4 c0 = {0.f, 0.f, 0.f, 0.f}, c1 = {0.f, 0.f, 0.f, 0.f};
#pragma unroll 4
        for (int j = 0; j < 256; ++j) { const float av = As[kk * 257 + j]; const f32x4 b0 = *(const LAS f32x4*)(Bs + j * 64 + nn), b1 = *(const LAS f32x4*)(Bs + j * 64 + nn + 4); c0 += b0 * av; c1 += b1 * av; }
        bf16_t* WT = (bf16_t*)(a.ws + WS_WIN) + (size_t)(4096 + g * 256 + n0 + nn) * 1024 + k0 + kk;
#pragma unroll
        for (int e = 0; e < 4; ++e) { WT[(size_t)e * 1024] = (bf16_t)f2bf(c0[e]); WT[(size_t)(e + 4) * 1024] = (bf16_t)f2bf(c1[e]); }
        __syncthreads();
    }
    {
        LAS float* scr = (LAS float*)(lds + wave * 16384);
        const int gw = blk * NWAVES + wave, NGW = gridDim.x * NWAVES;
        constexpr int I_IN = (DM / 64) * (NPROJ / 32), I_SQ = (DM / 64) * (DM / 32);
        for (int it = gw; it < I_IN + 3 * I_SQ; it += NGW) {
            int r = it;
            if (r < I_IN) { const int nb = r % (NPROJ / 32); if (nb < 128 || nb >= 160) p0_transpose_item(a.w_in, DM, NPROJ, (bf16_t*)(a.ws + WS_WIN), 0, scr, r, lane); continue; } r -= I_IN;
            if (r < I_SQ) { p0_transpose_item(a.w_a, DM, DM, (bf16_t*)(a.ws + WS_WA), 0, scr, r, lane); continue; } r -= I_SQ;
            if (r < I_SQ) { p0_transpose_item(a.w_b, DM, DM, (bf16_t*)(a.ws + WS_WB), 0, scr, r, lane); continue; } r -= I_SQ;
            p0_transpose_item(a.w_out, DM, DM, (bf16_t*)(a.ws + WS_WO), 0, scr, r, lane);
        }
    }
}

__device__ __forceinline__ void p1_prenorm(const Args& a, int lane, int wave) {
    const int gw = blockIdx.x * NWAVES + wave, NGW = gridDim.x * NWAVES;
    bf16_t* H = (bf16_t*)(a.ws + WS_H);
    for (int rb = gw; rb < MTOK / 32; rb += NGW) {
        const int b = rb >> 6; const float* mod = (const float*)(a.ws + WS_MOD) + (size_t)b * 3072;
        f32x4 ca[4], cs[4];
#pragma unroll
        for (int j = 0; j < 4; ++j) { const int c = 4 * lane + 256 * j; const f32x4 g = *(const f32x4*)(a.norm_gain + c), sc = *(const f32x4*)(mod + 1024 + c); ca[j] = g * (sc + 1.0f); cs[j] = *(const f32x4*)(mod + c); }
#pragma unroll 2
        for (int r = 0; r < 32; ++r) { const size_t row = (size_t)rb * 32 + r; const f32x4* xr = (const f32x4*)(a.x + row * DM) + lane;
            f32x4 v[4]; float s = 0.f;
#pragma unroll
            for (int j = 0; j < 4; ++j) { v[j] = xr[64 * j]; s += (v[j].x * v[j].x + v[j].y * v[j].y) + (v[j].z * v[j].z + v[j].w * v[j].w); }
            const float rstd = 1.0f / sqrtf(wave_sum(s) * (1.0f / DM) + EPS);
            u32x2* o8 = (u32x2*)(H + row * DM) + lane;
#pragma unroll
            for (int j = 0; j < 4; ++j) { const f32x4 o = v[j] * rstd * ca[j] + cs[j]; u32x2 w; w.x = cvt_pk_bf16(o.x, o.y); w.y = cvt_pk_bf16(o.z, o.w); o8[64 * j] = w; } }
    }
}
__device__ __forceinline__ void p6_final_norm(const Args& a, int lane, int wave) {
    const int gw = blockIdx.x * NWAVES + wave, NGW = gridDim.x * NWAVES;
    f32x4 fg[4];
#pragma unroll
    for (int j = 0; j < 4; ++j) fg[j] = *(const f32x4*)(a.final_gain + 4 * lane + 256 * j);
    for (int rb = gw; rb < MTOK / 32; rb += NGW) {
#pragma unroll 2
        for (int r = 0; r < 32; ++r) { const size_t row = (size_t)rb * 32 + r; f32x4* yr = (f32x4*)(a.out + row * DM) + lane;
            f32x4 v[4]; float s = 0.f;
#pragma unroll
            for (int j = 0; j < 4; ++j) { v[j] = yr[64 * j]; s += (v[j].x * v[j].x + v[j].y * v[j].y) + (v[j].z * v[j].z + v[j].w * v[j].w); }
            const float rstd = 1.0f / sqrtf(wave_sum(s) * (1.0f / DM) + EPS);
#pragma unroll
            for (int j = 0; j < 4; ++j) yr[64 * j] = v[j] * rstd * fg[j]; }
    }
}

__device__ __forceinline__ bf16x8 ldg8(const bf16_t* p) { return *(const bf16x8*)p; }
__device__ __forceinline__ void attn_unit(const bf16_t* __restrict__ Q, const bf16_t* __restrict__ K, const bf16_t* __restrict__ VT, const bf16_t* __restrict__ ZA, bf16_t* __restrict__ AG,
                                          int bl, int h, int qb, int lane) {
    const int ql = lane & 15, fq = lane >> 4, t0 = qb * 32;
    const size_t rowbase = (size_t)bl * SEQ;
    const bf16_t* Qp = Q + (rowbase + t0 + ql) * DM + h * 64 + 8 * fq;
    bf16x8 qf[2][2];
#pragma unroll
    for (int gq = 0; gq < 2; ++gq)
#pragma unroll
        for (int kh = 0; kh < 2; ++kh) qf[gq][kh] = ldg8(Qp + (size_t)gq * 16 * DM + kh * 32);
    const bf16_t* Kp = K + rowbase * DM + h * 64 + 8 * fq;
    const bf16_t* Vp = VT + ((size_t)bl * DM + h * 64 + ql) * SEQ;
    f32x4 o[4][2];
#pragma unroll
    for (int db = 0; db < 4; ++db) { o[db][0] = (f32x4){0.f, 0.f, 0.f, 0.f}; o[db][1] = (f32x4){0.f, 0.f, 0.f, 0.f}; }
    float rp[2] = {1.f, 1.f};
    const int kperm = 16 * (ql >> 2) + (ql & 3);
    constexpr float C2 = 0.125f * 1.4426950408889634f, THR = 7.8886090522101181e-31f;
    for (int jt = 0;; ++jt) {
        const int ks = t0 - 32 - 64 * jt;
        if (ks + 64 <= 0) break;
        bf16x8 kf[4][2], vf[4][2];
#pragma unroll
        for (int b = 0; b < 4; ++b) { int key = ks + kperm + 4 * b; key = key < 0 ? 0 : key;
#pragma unroll
            for (int kh = 0; kh < 2; ++kh) kf[b][kh] = ldg8(Kp + (size_t)key * DM + kh * 32); }
#pragma unroll
        for (int hv = 0; hv < 2; ++hv) { int key0 = ks + 16 * fq + 8 * hv; key0 = key0 < 0 ? 0 : key0;
#pragma unroll
            for (int db = 0; db < 4; ++db) vf[db][hv] = ldg8(Vp + (size_t)db * 16 * SEQ + key0); }
        f32x4 s[4][2];
#pragma unroll
        for (int b = 0; b < 4; ++b)
#pragma unroll
            for (int gq = 0; gq < 2; ++gq) { s[b][gq] = __builtin_amdgcn_mfma_f32_16x16x32_bf16(kf[b][0], qf[gq][0], (f32x4){0.f, 0.f, 0.f, 0.f}, 0, 0, 0);
                s[b][gq] = __builtin_amdgcn_mfma_f32_16x16x32_bf16(kf[b][1], qf[gq][1], s[b][gq], 0, 0, 0); }
        bf16x8 pf[2][2];
#pragma unroll
        for (int gq = 0; gq < 2; ++gq) {
            const int t = t0 + 16 * gq + ql;
            float om[16], be[16];
#pragma unroll
            for (int b = 0; b < 4; ++b)
#pragma unroll
                for (int i = 0; i < 4; ++i) { const int e = 4 * b + i, key = ks + 16 * fq + e; const bool valid = (key >= 0) && (key < t);
                    const float xs = fminf(s[b][gq][i] * C2, 60.f), ex = __builtin_amdgcn_exp2f(xs), omv = __builtin_amdgcn_rcpf(1.0f + ex);
                    om[e] = valid ? omv : 1.0f; be[e] = valid ? ex * omv : 0.0f; }
            float sp = 1.0f;
#pragma unroll
            for (int e = 15; e >= 0; --e) { const float tmp = om[e]; om[e] = sp; sp *= tmp; }
            const float T0 = __shfl(sp, ql), T1 = __shfl(sp, ql + 16), T2 = __shfl(sp, ql + 32), T3 = __shfl(sp, ql + 48);
            const float X = (fq < 1 ? T1 : 1.0f) * (fq < 2 ? T2 : 1.0f) * (fq < 3 ? T3 : 1.0f);
            const float f = X * rp[gq];
            rp[gq] *= (T0 * T1) * (T2 * T3);
            float w[16];
#pragma unroll
            for (int e = 0; e < 16; ++e) w[e] = be[e] * om[e] * f;
#pragma unroll
            for (int hv = 0; hv < 2; ++hv) { u32x4 pw; pw.x = cvt_pk_bf16(w[8 * hv], w[8 * hv + 1]); pw.y = cvt_pk_bf16(w[8 * hv + 2], w[8 * hv + 3]); pw.z = cvt_pk_bf16(w[8 * hv + 4], w[8 * hv + 5]); pw.w = cvt_pk_bf16(w[8 * hv + 6], w[8 * hv + 7]);
                pf[hv][gq] = __builtin_bit_cast(bf16x8, pw); }
        }
#pragma unroll
        for (int db = 0; db < 4; ++db)
#pragma unroll
            for (int gq = 0; gq < 2; ++gq) { o[db][gq] = __builtin_amdgcn_mfma_f32_16x16x32_bf16(vf[db][0], pf[0][gq], o[db][gq], 0, 0, 0);
                o[db][gq] = __builtin_amdgcn_mfma_f32_16x16x32_bf16(vf[db][1], pf[1][gq], o[db][gq], 0, 0, 0); }
        if (__all(fmaxf(rp[0], rp[1]) < THR)) break;
    }
#pragma unroll
    for (int gq = 0; gq < 2; ++gq)
#pragma unroll
        for (int db = 0; db < 4; ++db) { const size_t off = (rowbase + t0 + 16 * gq + ql) * DM + h * 64 + 16 * db + 4 * fq;
            const u32x2 z = *(const u32x2*)(ZA + off); const f32x4 ov = o[db][gq];
            u32x2 w; w.x = cvt_pk_bf16(ov[0] * bf_lo(z.x), ov[1] * bf_hi(z.x)); w.y = cvt_pk_bf16(ov[2] * bf_lo(z.y), ov[3] * bf_hi(z.y)); *(u32x2*)(AG + off) = w; }
}
__device__ __forceinline__ f32x4 ld4bf(const bf16_t* p) { const u32x2 w = *(const u32x2*)p; return (f32x4){bf_lo(w.x), bf_hi(w.x), bf_lo(w.y), bf_hi(w.y)}; }
__device__ __forceinline__ void pool_unit(const bf16_t* __restrict__ Y, const bf16_t* __restrict__ ZB, const float* __restrict__ pscale, bf16_t* __restrict__ BG, int bl, int g, int tb, int lane) {
    const int ch = g * 256 + lane * 4, win = 2 << g, t0 = tb * 32;
    const size_t base = (size_t)bl * SEQ * DM + ch;
    const f32x4 ps = *(const f32x4*)(pscale + ch);
    f32x4 run = {0.f, 0.f, 0.f, 0.f};
    for (int tt = t0 - win; tt < t0; ++tt) if (tt >= 0) run += ld4bf(Y + base + (size_t)tt * DM);
#pragma unroll 4
    for (int t = t0; t < t0 + 32; ++t) {
        const f32x4 yv = ld4bf(Y + base + (size_t)t * DM), zb = ld4bf(ZB + base + (size_t)t * DM);
        run += yv;
        if (t - win >= 0) run -= ld4bf(Y + base + (size_t)(t - win) * DM);
        const int cnt = (t + 1 < win) ? (t + 1) : win;
        const f32x4 d = run * (1.0f / (float)cnt) - yv, ov = d * ps * zb;
        u32x2 w; w.x = cvt_pk_bf16(ov[0], ov[1]); w.y = cvt_pk_bf16(ov[2], ov[3]); *(u32x2*)(BG + base + (size_t)t * DM) = w;
    }
}

__global__ void __launch_bounds__(NTHREADS) hybrid_fwd(Args a) {
    extern __shared__ __attribute__((aligned(16))) unsigned char lds_raw[];
    LAS unsigned char* lds = (LAS unsigned char*)lds_raw;
    cg::grid_group grid = cg::this_grid();
    const int tid = threadIdx.x, lane = tid & 63, wave = __builtin_amdgcn_readfirstlane(tid >> 6);
    const int G = gridDim.x;
    unsigned char* ws = a.ws;
    bf16_t* H = (bf16_t*)(ws + WS_H); bf16_t* PROJ = (bf16_t*)(ws + WS_PROJ);
    bf16_t* AGb = (bf16_t*)(ws + WS_AG); bf16_t* BGb = (bf16_t*)(ws + WS_BG); bf16_t* MG = (bf16_t*)(ws + WS_MG);
    const bf16_t* WIN = (const bf16_t*)(ws + WS_WIN); const bf16_t* WA = (const bf16_t*)(ws + WS_WA); const bf16_t* WB = (const bf16_t*)(ws + WS_WB); const bf16_t* WO = (const bf16_t*)(ws + WS_WO);

    volatile LAS unsigned* MISC = (volatile LAS unsigned*)(lds + MISC_OFF);
    if (tid < 64) MISC[tid] = 0u;
    __syncthreads();
    if (a.ws == nullptr) grid.sync();
    const XcdBarrier bar = xcd_barrier_post((unsigned*)ws, MISC + 8);
#define GRID_BAR() xcd_barrier(bar)
    p0_prologue(a, lds, tid, lane, wave);
    GRID_BAR();
    p1_prenorm(a, lane, wave);
    GRID_BAR();
    for (int ch = 0; ch < NCHUNK; ++ch) {
        { pg8::Gemm g{H + (size_t)ch * MC * DM, nullptr, WIN, nullptr, MC, NPROJ, DM}; pg8::StaticOrder S; S.init(MC, NPROJ, G, (int)blockIdx.x, 0);
          pg8::EpiProj E{PROJ}; pg8::gemm_phase<pg8::EpiProj, true, true>(lds, g, S, E); }
        GRID_BAR();
        { const int gw = blockIdx.x * NWAVES + wave, NGW = G * NWAVES;
          const bf16_t* Qb = PROJ; const bf16_t* Kb = PROJ + pg8::SEG_ELEMS; const bf16_t* VTb = PROJ + 2 * pg8::SEG_ELEMS; const bf16_t* ZAb = PROJ + 3 * pg8::SEG_ELEMS;
          const bf16_t* Yb = PROJ + 4 * pg8::SEG_ELEMS; const bf16_t* ZBb = PROJ + 5 * pg8::SEG_ELEMS;
          for (int U = gw; U < BPC * NH * 64; U += NGW) { const int bh = U >> 6, qb = U & 63; attn_unit(Qb, Kb, VTb, ZAb, AGb, bh >> 4, bh & 15, qb, lane); }
          for (int U = gw; U < BPC * 4 * 64; U += NGW) { pool_unit(Yb, ZBb, a.pool_scale, BGb, U >> 8, (U >> 6) & 3, U & 63, lane); } }
        GRID_BAR();
        { pg8::Gemm g{AGb, BGb, WA, WB, MC, DM, DM}; pg8::StaticOrder S; S.init(MC, DM, G, (int)blockIdx.x, 1);
          pg8::EpiMerge E{PROJ + 6 * pg8::SEG_ELEMS, PROJ + 7 * pg8::SEG_ELEMS, MG}; pg8::gemm_phase<pg8::EpiMerge, true, true>(lds, g, S, E); }
        GRID_BAR();
        { pg8::Gemm g{MG, nullptr, WO, nullptr, MC, DM, DM}; pg8::StaticOrder S; S.init(MC, DM, G, (int)blockIdx.x, 0);
          pg8::EpiOut E{a.x, (const float*)(ws + WS_MOD), a.out, ch * MC}; pg8::gemm_phase<pg8::EpiOut, true, true>(lds, g, S, E); }
    }
    GRID_BAR();
    p6_final_norm(a, lane, wave);
}

extern "C" void kernel_launch(void* const* d_in, const int* in_sizes, int n_in, void* d_out, int out_size, void* d_ws, size_t ws_size, hipStream_t stream) {
    static int grid = 0;
    if (grid == 0) {
        if (n_in != 12 || in_sizes[0] != MTOK * DM || out_size != MTOK * DM || ws_size < WS_END) { fprintf(stderr, "kernel_launch: unexpected shapes (n_in %d, in0 %d, out %d, ws %zu)\n", n_in, n_in > 0 ? in_sizes[0] : -1, out_size, ws_size); grid = -1; return; }
        int dev = 0, cus = 0, per_cu = 0;
        if (hipGetDevice(&dev) != hipSuccess || hipDeviceGetAttribute(&cus, hipDeviceAttributeMultiprocessorCount, dev) != hipSuccess) { grid = -1; return; }
        if (hipFuncSetAttribute((const void*)hybrid_fwd, hipFuncAttributeMaxDynamicSharedMemorySize, LDS_BYTES) != hipSuccess) { fprintf(stderr, "kernel_launch: hipFuncSetAttribute failed\n"); grid = -1; return; }
        if (hipOccupancyMaxActiveBlocksPerMultiprocessor(&per_cu, (const void*)hybrid_fwd, NTHREADS, LDS_BYTES) != hipSuccess || per_cu < 1) { fprintf(stderr, "kernel_launch: occupancy query says %d\n", per_cu); per_cu = 1; }
        (void)hipGetLastError();
        grid = cus;
    }
    if (grid < 0) return;
    Args a{};
    a.x = (const float*)d_in[0]; a.c = (const float*)d_in[1]; a.norm_gain = (const float*)d_in[2]; a.w_ada = (const float*)d_in[3]; a.b_ada = (const float*)d_in[4];
    a.w_in = (const float*)d_in[5]; a.pool_w = (const float*)d_in[6]; a.pool_scale = (const float*)d_in[7]; a.w_a = (const float*)d_in[8]; a.w_b = (const float*)d_in[9];
    a.w_out = (const float*)d_in[10]; a.final_gain = (const float*)d_in[11]; a.out = (float*)d_out; a.ws = (unsigned char*)d_ws;
    if (hipMemsetAsync(d_ws, 0, 65536, stream) != hipSuccess) { fprintf(stderr, "kernel_launch: memset failed\n"); return; }
    void* args[] = {&a};
    hipError_t e = hipLaunchCooperativeKernel((const void*)hybrid_fwd, dim3(grid), dim3(NTHREADS), args, LDS_BYTES, stream);
    if (e != hipSuccess) fprintf(stderr, "kernel_launch: cooperative launch failed: %s (grid %d)\n", hipGetErrorString(e), grid);
}
```

```cpp
#include <hip/hip_runtime.h>
#include <hip/hip_cooperative_groups.h>
#include <cstdio>
#include <cstdint>
namespace cg = cooperative_groups;

namespace pg8 {
#define PG8_LAS __attribute__((address_space(3)))
typedef unsigned short bf16_t;
typedef short bf16x8 __attribute__((ext_vector_type(8)));
typedef float f32x4 __attribute__((ext_vector_type(4)));
typedef unsigned u32x4 __attribute__((ext_vector_type(4)));
typedef unsigned u32x2 __attribute__((ext_vector_type(2)));
constexpr int BM = 256, BK = 64, HALF = 128, HTB = HALF * BK * 2  , STAGE_BYTES = 8 * HTB, NXCD = 8, WGM = 8;

__host__ __device__ __forceinline__ int lds_byte(int r, int c) { const int st = (r >> 4) * 2 + (c >> 5), rr = r & 15, cc = c & 31, ob = rr * 64 + cc * 2; return st * 1024 + (ob ^ (((ob >> 9) & 1) << 5)); }
__host__ __device__ __forceinline__ void stage_rc(int b, int& R, int& C) { const int st = b / 1024, sb = b % 1024, swz = sb ^ (((sb >> 9) & 1) << 5); R = (st >> 1) * 16 + swz / 64; C = (st & 1) * 32 + (swz % 64) / 2; }
__host__ __device__ __forceinline__ int perm32(int rho) { const int n = rho >> 4, i = rho & 15; return 8 * (i >> 2) + 4 * n + (i & 3); }

struct Unit { int pm, pn, sel; };
struct Gemm { const bf16_t* A0; const bf16_t* A1; const bf16_t* B0; const bf16_t* B1; int M, N, K; };

struct StaticOrder {
    int nM, nN, nwg, G, c, pair;
    __host__ __device__ void init(int M, int N, int G_, int c_, int pair_) { nM = M / BM; nN = N / BM; nwg = nM * nN; G = G_; c = c_; pair = pair_; }
    __host__ __device__ bool next(int ii, Unit& u) const {
        const int i = pair ? (ii >> 1) : ii; u.sel = pair ? (ii & 1) : 0;
        const long L = (long)i * G + c; if (L >= nwg) return false;
        int wgid = (int)L; { const int q = nwg / NXCD, r = nwg % NXCD, xcd = wgid % NXCD, off = wgid / NXCD; wgid = (xcd < r ? xcd * (q + 1) : r * (q + 1) + (xcd - r) * q) + off; }
        const int nig = WGM * nN, gid = wgid / nig, fm = gid * WGM, gsz = (nM - fm) < WGM ? (nM - fm) : WGM;
        u.pm = fm + ((wgid % nig) % gsz); u.pn = (wgid % nig) / gsz; return true;
    }
};

__device__ __forceinline__ unsigned cvt_pk_bf16(float lo, float hi) { unsigned r; asm("v_cvt_pk_bf16_f32 %0, %1, %2" : "=v"(r) : "v"(lo), "v"(hi)); return r; }
__device__ __forceinline__ float bf_lo(unsigned w) { return __uint_as_float(w << 16); }
__device__ __forceinline__ float bf_hi(unsigned w) { return __uint_as_float(w & 0xffff0000u); }
__device__ __forceinline__ float fast_sigmoid(float x) { return __builtin_amdgcn_rcpf(1.0f + __expf(-x)); }

constexpr int PROJ_ROWS = 32768;
constexpr size_t SEG_ELEMS = (size_t)PROJ_ROWS * 1024;
struct EpiProj {
    static constexpr bool PERM = true, PAIR = false;
    bf16_t* P;
    __device__ __forceinline__ void operator()(f32x4 (&acc)[2][2][4][2], const Unit& u, int wr, int wc, int fr, int fq) const {
        const int sg = u.pn >> 2, colt = (u.pn & 3) * BM;
        const int row0 = u.pm * BM + wr * 64 + fr, col0 = colt + wc * 32 + 8 * fq;
        bf16_t* base = P + (size_t)sg * SEG_ELEMS;
        if (sg == 2) {
#pragma unroll
            for (int ai = 0; ai < 2; ++ai)
#pragma unroll
                for (int m = 0; m < 4; ++m) { const int r = row0 + ai * HALF + m * 16; bf16_t* vp = base + ((size_t)(r >> 11) * 1024 + col0) * 2048 + (r & 2047);
#pragma unroll
                    for (int bj = 0; bj < 2; ++bj)
#pragma unroll
                        for (int n = 0; n < 2; ++n)
#pragma unroll
                            for (int j = 0; j < 4; ++j) { const float v = acc[ai][bj][m][n][j]; vp[(size_t)(bj * HALF + 4 * n + j) * 2048] = (bf16_t)(cvt_pk_bf16(v, v) & 0xffffu); } }
        } else {
            const int act = (sg == 3 || sg == 5) ? 1 : (sg >= 6 ? 2 : 0);
#pragma unroll
            for (int ai = 0; ai < 2; ++ai)
#pragma unroll
                for (int m = 0; m < 4; ++m) { bf16_t* rowp = base + (size_t)(row0 + ai * HALF + m * 16) * 1024 + col0;
#pragma unroll
                    for (int bj = 0; bj < 2; ++bj) { f32x4 v0 = acc[ai][bj][m][0], v1 = acc[ai][bj][m][1];
                        if (act) {
#pragma unroll
                            for (int j = 0; j < 4; ++j) { const float s0 = fast_sigmoid(v0[j]), s1 = fast_sigmoid(v1[j]); v0[j] = (act == 1) ? v0[j] * s0 : s0; v1[j] = (act == 1) ? v1[j] * s1 : s1; } }
                        u32x4 w; w.x = cvt_pk_bf16(v0[0], v0[1]); w.y = cvt_pk_bf16(v0[2], v0[3]); w.z = cvt_pk_bf16(v1[0], v1[1]); w.w = cvt_pk_bf16(v1[2], v1[3]);
                        *(u32x4*)(rowp + bj * HALF) = w; } }
        }
    }
};
struct EpiMerge {
    static constexpr bool PERM = true, PAIR = true;
    const bf16_t* SA; const bf16_t* SB; bf16_t* O;
    __device__ __forceinline__ void operator()(f32x4 (&acc)[2][2][4][2], const Unit& u, int wr, int wc, int fr, int fq) const {
        const int row0 = u.pm * BM + wr * 64 + fr, col0 = u.pn * BM + wc * 32 + 8 * fq;
#pragma unroll
        for (int ai = 0; ai < 2; ++ai)
#pragma unroll
            for (int m = 0; m < 4; ++m) { const size_t off = (size_t)(row0 + ai * HALF + m * 16) * 1024 + col0;
#pragma unroll
                for (int bj = 0; bj < 2; ++bj) {
                    const u32x4 sbw = *(const u32x4*)(SB + off + bj * HALF);
                    float sb[8];
#pragma unroll
                    for (int j = 0; j < 4; ++j) { sb[2 * j] = fmaxf(bf_lo(sbw[j]), 1e-30f); sb[2 * j + 1] = fmaxf(bf_hi(sbw[j]), 1e-30f); }
                    if (u.sel == 0) {
                        const u32x4 saw = *(const u32x4*)(SA + off + bj * HALF);
#pragma unroll
                        for (int j = 0; j < 4; ++j) { const float r0 = bf_lo(saw[j]) * __builtin_amdgcn_rcpf(sb[2 * j]), r1 = bf_hi(saw[j]) * __builtin_amdgcn_rcpf(sb[2 * j + 1]);
                            if (j < 2) { acc[ai][bj][m][0][2 * j] *= r0; acc[ai][bj][m][0][2 * j + 1] *= r1; } else { acc[ai][bj][m][1][2 * j - 4] *= r0; acc[ai][bj][m][1][2 * j - 3] *= r1; } }
                    } else {
                        const f32x4 v0 = acc[ai][bj][m][0], v1 = acc[ai][bj][m][1];
                        u32x4 w; w.x = cvt_pk_bf16(v0[0] * sb[0], v0[1] * sb[1]); w.y = cvt_pk_bf16(v0[2] * sb[2], v0[3] * sb[3]); w.z = cvt_pk_bf16(v1[0] * sb[4], v1[1] * sb[5]); w.w = cvt_pk_bf16(v1[2] * sb[6], v1[3] * sb[7]);
                        *(u32x4*)(O + off + bj * HALF) = w; } } }
    }
};
struct EpiOut {
    static constexpr bool PERM = false, PAIR = false;
    const float* x; const float* mod; float* out; int row_off;
    __device__ __forceinline__ void operator()(f32x4 (&acc)[2][2][4][2], const Unit& u, int wr, int wc, int fr, int fq) const {
        const int R0 = row_off + u.pm * BM + wr * 64 + fr, col0 = u.pn * BM + wc * 32 + 4 * fq;
        const float* gate = mod + (size_t)((row_off + u.pm * BM) >> 11) * 3072 + 2048;
        f32x4 gv[2][2];
#pragma unroll
        for (int bj = 0; bj < 2; ++bj)
#pragma unroll
            for (int n = 0; n < 2; ++n) gv[bj][n] = *(const f32x4*)(gate + col0 + bj * HALF + n * 16);
#pragma unroll
        for (int ai = 0; ai < 2; ++ai)
#pragma unroll
            for (int m = 0; m < 4; ++m) { const size_t off = (size_t)(R0 + ai * HALF + m * 16) * 1024 + col0;
#pragma unroll
                for (int bj = 0; bj < 2; ++bj)
#pragma unroll
                    for (int n = 0; n < 2; ++n) { const f32x4 xv = *(const f32x4*)(x + off + bj * HALF + n * 16); *(f32x4*)(out + off + bj * HALF + n * 16) = xv + gv[bj][n] * acc[ai][bj][m][n]; } }
    }
};

template <class Epi, bool ALIGN_EPI, bool SP2>
__device__ __forceinline__ void gemm_phase(PG8_LAS unsigned char* lds, const Gemm g, const StaticOrder& S, const Epi& E) {
    int tid_l = threadIdx.x; asm volatile("" : "+v"(tid_l));
    const int tid = tid_l, wid = __builtin_amdgcn_readfirstlane(tid >> 6), lane = tid & 63, wr = wid >> 2, wc = wid & 3, fr = lane & 15, fq = lane >> 4;
    const int K = g.K, nt = K / BK;
    unsigned voffA[2], voffB[2];
#pragma unroll
    for (int i = 0; i < 2; ++i) { int R, C; stage_rc(tid * 16 + i * 8192, R, C); const int Rb = Epi::PERM ? ((R & ~31) + perm32(R & 31)) : R;
        voffA[i] = (unsigned)(R * K + C) * 2u; voffB[i] = (unsigned)(Rb * K + C) * 2u; }
    const size_t kstep = (size_t)(BK * 2);
    const size_t hstep = (size_t)HALF * K * 2;
    const size_t tstep = 2 * hstep;
    const unsigned ldsw = (unsigned)wid * 1024u;
    const int aoff = lds_byte(wr * 64 + fr, fq * 8), boff = lds_byte(wc * 32 + fr, fq * 8);
#define PG8_SA(b, h) (((b) * 2 + (h)) * HTB)
#define PG8_SB(b, h) ((4 + (b) * 2 + (h)) * HTB)
#define PG8_STAGE(bufoff, gbase, voff) do { _Pragma("unroll") for (int _i = 0; _i < 2; ++_i) \
        __builtin_amdgcn_global_load_lds((const unsigned*)((const char*)(gbase) + (voff)[_i]), (PG8_LAS unsigned*)(lds + (bufoff) + ldsw + _i * 8192), 16, 0, 0); } while (0)
#define PG8_LDA(dst, b, h) do { _Pragma("unroll") for (int m = 0; m < 4; ++m) _Pragma("unroll") for (int k = 0; k < 2; ++k) dst[m][k] = *(const PG8_LAS bf16x8*)(lds + PG8_SA(b, h) + aoff + m * 2048 + k * 1024); } while (0)
#define PG8_LDB(dst, b, h) do { _Pragma("unroll") for (int n = 0; n < 2; ++n) _Pragma("unroll") for (int k = 0; k < 2; ++k) dst[n][k] = *(const PG8_LAS bf16x8*)(lds + PG8_SB(b, h) + boff + n * 2048 + k * 1024); } while (0)
#define PG8_MMA(ai, bj, At, Bt) do { __builtin_amdgcn_s_setprio(1); _Pragma("unroll") for (int m = 0; m < 4; ++m) _Pragma("unroll") for (int n = 0; n < 2; ++n) _Pragma("unroll") for (int k = 0; k < 2; ++k) \
        acc[ai][bj][m][n] = __builtin_amdgcn_mfma_f32_16x16x32_bf16(Bt[n][k], At[m][k], acc[ai][bj][m][n], 0, 0, 0); __builtin_amdgcn_s_setprio(0); } while (0)
#define PG8_WAIT_V(n) asm volatile("s_waitcnt vmcnt(" #n ")" ::: "memory")
#define PG8_WAIT_L(n) asm volatile("s_waitcnt lgkmcnt(" #n ")" ::: "memory")
#define PG8_BAR __builtin_amdgcn_s_barrier()
#define PG8_SCHED __builtin_amdgcn_sched_barrier(0)
    Unit cur, nxt; int ui = 0;
    if (!S.next(0, cur)) return;
    f32x4 acc[2][2][4][2];
#pragma unroll
    for (int a = 0; a < 2; ++a)
#pragma unroll
        for (int b = 0; b < 2; ++b)
#pragma unroll
            for (int m = 0; m < 4; ++m)
#pragma unroll
                for (int n = 0; n < 2; ++n) acc[a][b][m][n] = (f32x4){0.f, 0.f, 0.f, 0.f};
    bf16x8 At[4][2], B0[2][2], B1[2][2];
    const char* cA = (const char*)(cur.sel ? g.A1 : g.A0) + (size_t)cur.pm * tstep; const char* cB = (const char*)(cur.sel ? g.B1 : g.B0) + (size_t)cur.pn * tstep;
    if constexpr (SP2) {
        PG8_STAGE(PG8_SB(0, 0), cB, voffB); PG8_STAGE(PG8_SB(0, 1), cB + hstep, voffB); PG8_STAGE(PG8_SA(0, 0), cA, voffA); PG8_STAGE(PG8_SA(0, 1), cA + hstep, voffA);
        if (wr == 1) PG8_BAR;
        PG8_WAIT_V(2); PG8_BAR;
        PG8_STAGE(PG8_SB(1, 0), cB + kstep, voffB); PG8_STAGE(PG8_SA(1, 0), cA + kstep, voffA); PG8_STAGE(PG8_SB(1, 1), cB + hstep + kstep, voffB);
        PG8_WAIT_V(6); PG8_BAR;
    } else {
        PG8_STAGE(PG8_SB(0, 0), cB, voffB); PG8_STAGE(PG8_SA(0, 0), cA, voffA); PG8_STAGE(PG8_SB(0, 1), cB + hstep, voffB); PG8_STAGE(PG8_SA(0, 1), cA + hstep, voffA);
        if (wr == 1) PG8_BAR;
        PG8_WAIT_V(4); PG8_BAR;
        PG8_STAGE(PG8_SB(1, 0), cB + kstep, voffB); PG8_STAGE(PG8_SA(1, 0), cA + kstep, voffA); PG8_STAGE(PG8_SB(1, 1), cB + hstep + kstep, voffB);
        PG8_WAIT_V(6); PG8_BAR;
    }
    for (;;) {
        const bool has_next = S.next(ui + 1, nxt);
        const char* nA = has_next ? (const char*)(nxt.sel ? g.A1 : g.A0) + (size_t)nxt.pm * tstep : cA; const char* nB = has_next ? (const char*)(nxt.sel ? g.B1 : g.B0) + (size_t)nxt.pn * tstep : cB;
        for (int t = 0; t < nt; t += 2) {
            const bool last = (t == nt - 2);
            const char* a1 = cA + (size_t)(t + 1) * kstep;
            const char* a2 = last ? nA : cA + (size_t)(t + 2) * kstep; const char* b2 = last ? nB : cB + (size_t)(t + 2) * kstep;
            const char* a3 = a2 + kstep; const char* b3 = b2 + kstep;
            if constexpr (SP2) {
            PG8_LDB(B0, 0, 0); PG8_LDB(B1, 0, 1); PG8_SCHED; PG8_LDA(At, 0, 0); PG8_STAGE(PG8_SA(1, 1), a1 + hstep, voffA);
            PG8_WAIT_V(8); PG8_WAIT_L(0); PG8_BAR; PG8_MMA(0, 0, At, B0); PG8_MMA(0, 1, At, B1); PG8_BAR; PG8_SCHED;
            PG8_LDA(At, 0, 1); PG8_STAGE(PG8_SB(0, 0), b2, voffB); PG8_STAGE(PG8_SB(0, 1), b2 + hstep, voffB); PG8_STAGE(PG8_SA(0, 0), a2, voffA);
            PG8_WAIT_V(8); PG8_WAIT_L(0); PG8_BAR; PG8_MMA(1, 0, At, B0); PG8_MMA(1, 1, At, B1); PG8_BAR; PG8_SCHED;
            PG8_LDB(B0, 1, 0); PG8_LDB(B1, 1, 1); PG8_SCHED; PG8_LDA(At, 1, 0); PG8_STAGE(PG8_SA(0, 1), a2 + hstep, voffA);
            PG8_WAIT_V(8); PG8_WAIT_L(0); PG8_BAR; PG8_MMA(0, 0, At, B0); PG8_MMA(0, 1, At, B1); PG8_BAR; PG8_SCHED;
            PG8_LDA(At, 1, 1); PG8_STAGE(PG8_SB(1, 0), b3, voffB); PG8_STAGE(PG8_SB(1, 1), b3 + hstep, voffB); PG8_STAGE(PG8_SA(1, 0), a3, voffA);
            PG8_WAIT_V(8); PG8_WAIT_L(0); PG8_BAR; PG8_MMA(1, 0, At, B0); PG8_MMA(1, 1, At, B1); PG8_BAR; PG8_SCHED;
            } else {
            PG8_LDB(B0, 0, 0); PG8_SCHED; PG8_LDA(At, 0, 0); PG8_STAGE(PG8_SA(1, 1), a1 + hstep, voffA);
            PG8_WAIT_L(8); PG8_BAR; PG8_WAIT_L(0); PG8_MMA(0, 0, At, B0); PG8_BAR; PG8_SCHED;
            PG8_LDB(B1, 0, 1); PG8_STAGE(PG8_SB(0, 0), b2, voffB);
            PG8_BAR; PG8_WAIT_L(0); PG8_MMA(0, 1, At, B1); PG8_BAR;
            PG8_LDA(At, 0, 1); PG8_STAGE(PG8_SA(0, 0), a2, voffA);
            PG8_BAR; PG8_WAIT_L(0); PG8_MMA(1, 0, At, B0); PG8_BAR; PG8_SCHED;
            PG8_STAGE(PG8_SB(0, 1), b2 + hstep, voffB);
            PG8_WAIT_V(6); PG8_BAR; PG8_MMA(1, 1, At, B1); PG8_BAR;
            PG8_LDB(B0, 1, 0); PG8_SCHED; PG8_LDA(At, 1, 0); PG8_STAGE(PG8_SA(0, 1), a2 + hstep, voffA);
            PG8_WAIT_L(8); PG8_BAR; PG8_WAIT_L(0); PG8_MMA(0, 0, At, B0); PG8_BAR; PG8_SCHED;
            PG8_LDB(B1, 1, 1); PG8_STAGE(PG8_SB(1, 0), b3, voffB);
            PG8_BAR; PG8_WAIT_L(0); PG8_MMA(0, 1, At, B1); PG8_BAR;
            PG8_LDA(At, 1, 1); PG8_STAGE(PG8_SA(1, 0), a3, voffA);
            PG8_BAR; PG8_WAIT_L(0); PG8_MMA(1, 0, At, B0); PG8_BAR; PG8_SCHED;
            PG8_STAGE(PG8_SB(1, 1), b3 + hstep, voffB);
            PG8_WAIT_V(6); PG8_BAR; PG8_MMA(1, 1, At, B1); PG8_BAR;
            }
        }
        if constexpr (ALIGN_EPI) { if (wr == 0) PG8_BAR; }
        E(acc, cur, wr, wc, fr, fq);
        if (!has_next) break;
        if (!(Epi::PAIR && cur.sel == 0))
#pragma unroll
        for (int a = 0; a < 2; ++a)
#pragma unroll
            for (int b = 0; b < 2; ++b)
#pragma unroll
                for (int m = 0; m < 4; ++m)
#pragma unroll
                    for (int n = 0; n < 2; ++n) acc[a][b][m][n] = (f32x4){0.f, 0.f, 0.f, 0.f};
        cur = nxt; cA = nA; cB = nB; ++ui;
        if constexpr (ALIGN_EPI) { if (wr == 1) PG8_BAR; }
    }
    PG8_WAIT_V(0);
    if constexpr (!ALIGN_EPI) { if (wr == 0) PG8_BAR; }
    PG8_BAR;
#undef PG8_SA
#undef PG8_SB
#undef PG8_STAGE
#undef PG8_LDA
#undef PG8_LDB
#undef PG8_MMA
#undef PG8_WAIT_V
#undef PG8_WAIT_L
#undef PG8_BAR
#undef PG8_SCHED
}
}

#define LAS __attribute__((address_space(3)))
using pg8::bf16_t; using pg8::bf16x8; using pg8::f32x4; using pg8::u32x4; using pg8::u32x2; using pg8::cvt_pk_bf16; using pg8::bf_lo; using pg8::bf_hi;
constexpr int NB = 32, SEQ = 2048, DM = 1024, MTOK = NB * SEQ, NPROJ = 8192, NH = 16;
constexpr int NCHUNK = 2, MC = MTOK / NCHUNK, BPC = NB / NCHUNK;
static_assert(MC == pg8::PROJ_ROWS, "chunk rows");
constexpr float EPS = 1e-6f;
constexpr int NWAVES = 8, NTHREADS = 512, MISC_OFF = 147456, LDS_BYTES = MISC_OFF + 256;
constexpr size_t MiB = 1u << 20;
constexpr size_t WS_MOD = 1 * MiB;
constexpr size_t WS_WIN = 2 * MiB;
constexpr size_t WS_WA = 18 * MiB, WS_WB = 20 * MiB, WS_WO = 22 * MiB;
constexpr size_t WS_H = 24 * MiB;
constexpr size_t WS_PROJ = 152 * MiB;
constexpr size_t WS_AG = 664 * MiB, WS_BG = 728 * MiB, WS_MG = 792 * MiB, WS_END = 856 * MiB;

__device__ __forceinline__ float wave_sum(float v) {
#pragma unroll
    for (int o = 1; o < 64; o <<= 1) v += __shfl_xor(v, o);
    return v;
}
__device__ __forceinline__ unsigned f2bf(float f) { unsigned u = __builtin_bit_cast(unsigned, f); return (u + 0x7fffu + ((u >> 16) & 1u)) >> 16; }
__device__ __forceinline__ unsigned pk2(float lo, float hi) { return f2bf(lo) | (f2bf(hi) << 16); }

__device__ __forceinline__ void p0_transpose_item(const float* W, int K, int N, bf16_t* WT, int row_off, LAS float* scr, int item, int lane) {
    const int nblk = N / 32, kb = item / nblk, nb = item % nblk, k0 = 64 * kb, n0 = 32 * nb;
#pragma unroll 8
    for (int i = 0; i < 32; ++i) { const int kk = 2 * i + (lane >> 5); scr[kk * 33 + (lane & 31)] = W[(size_t)(k0 + kk) * N + n0 + (lane & 31)]; }
    asm volatile("s_waitcnt lgkmcnt(0)" ::: "memory");
    const int c = lane & 7;
#pragma unroll
    for (int j = 0; j < 4; ++j) { const int n = (lane >> 3) + 8 * j; const LAS float* s = scr + (8 * c) * 33 + n;
        u32x4 o; o.x = pk2(s[0 * 33], s[1 * 33]); o.y = pk2(s[2 * 33], s[3 * 33]); o.z = pk2(s[4 * 33], s[5 * 33]); o.w = pk2(s[6 * 33], s[7 * 33]);
        *(u32x4*)(WT + (size_t)(row_off + n0 + n) * K + k0 + 8 * c) = o; }
    asm volatile("s_waitcnt lgkmcnt(0)" ::: "memory");
}

#define XB_TMO      128
#define XB_XCNT(j)  (256  + 64 * (j))
#define XB_XSUB(j)  (1280 + 64 * (j))
#define XB_XGEN(j)  (2304 + 64 * (j))
#define XB_TOP      3328
#define XB_TOPGEN   3392
#define XCD_BAR_WORDS 3456
#define XB_SPIN_CAP (1u << 18)

__device__ __forceinline__ unsigned xb_ld(unsigned* p)              { return __hip_atomic_load(p, __ATOMIC_RELAXED, __HIP_MEMORY_SCOPE_AGENT); }
__device__ __forceinline__ unsigned xb_add(unsigned* p, unsigned v) { return __hip_atomic_fetch_add(p, v, __ATOMIC_RELAXED, __HIP_MEMORY_SCOPE_AGENT); }
__device__ __forceinline__ unsigned xb_xcc_id() { return (unsigned)__builtin_amdgcn_s_getreg((3 << 11) | 20) & 0xFu; }
#define XB_SPIN(cond, bar) do { unsigned _sp = 0; while (cond) { __builtin_amdgcn_s_sleep(1); \
    if ((++_sp & 255u) == 0u) { if (xb_ld(&(bar)[XB_TMO])) break; if (_sp > XB_SPIN_CAP) { atomicAdd(&(bar)[XB_TMO], 1u); break; } } } } while (0)

struct XcdBarrier {
    unsigned* bar; unsigned x;
    volatile LAS unsigned* st;
};

__device__ __forceinline__ XcdBarrier xcd_barrier_post(unsigned* bar, volatile LAS unsigned* st) {
    XcdBarrier b; b.bar = bar; b.x = xb_xcc_id(); b.st = st;
    if (threadIdx.x == 0) (void)xb_add(&bar[XB_XCNT(b.x)], 1u);
    return b;
}
__device__ __forceinline__ void xcd_barrier_complete(unsigned* bar, unsigned x, unsigned& nloc, unsigned& nx) {
    const unsigned G = gridDim.x * gridDim.y * gridDim.z;
    unsigned sum, cnt, mine, sp = 0u;
    for (;;) {
        sum = 0u; cnt = 0u; mine = 0u;
#pragma unroll
        for (unsigned j = 0; j < 16; ++j) { const unsigned c = xb_ld(&bar[XB_XCNT(j)]); sum += c; cnt += (c > 0u) ? 1u : 0u; mine = (j == x) ? c : mine; }
        if (sum == G) break;
        __builtin_amdgcn_s_sleep(1);
        if ((++sp & 255u) == 0u) { if (xb_ld(&bar[XB_TMO])) break; if (sp > XB_SPIN_CAP) { atomicAdd(&bar[XB_TMO], 1u); break; } }
    }
    nloc = mine > 0u ? mine : 1u; nx = cnt > 0u ? cnt : 1u;
}

__device__ __forceinline__ void xcd_barrier(const XcdBarrier& b) {
    asm volatile("s_waitcnt vmcnt(0)" ::: "memory");
    __syncthreads();
    if (threadIdx.x == 0) {
        unsigned* bar = b.bar;
        __builtin_amdgcn_s_waitcnt(0);
        unsigned nloc = b.st[0], nx = b.st[1];
        if (nloc == 0u) { xcd_barrier_complete(bar, b.x, nloc, nx); b.st[0] = nloc; b.st[1] = nx; }
        const unsigned old = xb_add(&bar[XB_XSUB(b.x)], 1u);
        const unsigned gen = old / nloc;
        if (old + 1u == (gen + 1u) * nloc) {
            __builtin_amdgcn_fence(__ATOMIC_RELEASE, "agent");
            asm volatile("s_waitcnt vmcnt(0)" ::: "memory");
            const unsigned og = xb_add(&bar[XB_TOP], 1u);
            const unsigned tg = og / nx;
            if (og + 1u == (tg + 1u) * nx) xb_add(&bar[XB_TOPGEN], 1u);
            else XB_SPIN(xb_ld(&bar[XB_TOPGEN]) == tg, bar);
            __builtin_amdgcn_fence(__ATOMIC_ACQUIRE, "agent");
            xb_add(&bar[XB_XGEN(b.x)], 1u);
            asm volatile("s_waitcnt vmcnt(0)" ::: "memory");
        } else {
            XB_SPIN(xb_ld(&bar[XB_XGEN(b.x)]) == gen, bar);
            __builtin_amdgcn_fence(__ATOMIC_ACQUIRE, "agent");
            asm volatile("s_waitcnt vmcnt(0)" ::: "memory");
        }
    }
    __syncthreads();
}

struct Args {
    const float* x; const float* c; const float* norm_gain; const float* w_ada; const float* b_ada; const float* w_in; const float* pool_w; const float* pool_scale;
    const float* w_a; const float* w_b; const float* w_out; const float* final_gain; float* out; unsigned char* ws;
};

__device__ __forceinline__ void p0_prologue(const Args& a, LAS unsigned char* lds, int tid, int lane, int wave) {
    const int blk = blockIdx.x;
    if (blk < 192) {
        LAS float* sc = (LAS float*)lds;
        for (int i = tid; i < NB * DM; i += NTHREADS) { const int b = i >> 10, k = i & 1023; const float v = a.c[i]; sc[k * 36 + b] = v * pg8::fast_sigmoid(v); }
        __syncthreads();
        const int kpart = tid >> 4, col = tid & 15, n = blk * 16 + col;
        float acc[32];
#pragma unroll
        for (int b = 0; b < 32; ++b) acc[b] = 0.f;
        for (int kk = 0; kk < 32; ++kk) { const int k = kpart * 32 + kk; const float w = a.w_ada[(size_t)k * 3072 + n];
#pragma unroll
            for (int b4 = 0; b4 < 8; ++b4) { const f32x4 s = *(const LAS f32x4*)(sc + k * 36 + 4 * b4); acc[4 * b4] += s[0] * w; acc[4 * b4 + 1] += s[1] * w; acc[4 * b4 + 2] += s[2] * w; acc[4 * b4 + 3] += s[3] * w; } }
        __syncthreads();
        LAS float* red = (LAS float*)lds;
#pragma unroll
        for (int b = 0; b < 32; ++b) red[(kpart * 32 + b) * 16 + col] = acc[b];
        __syncthreads();
        { const int b = tid >> 4; float s = 0.f;
            for (int kp = 0; kp < 32; ++kp) s += red[kp * 512 + tid];
            ((float*)(a.ws + WS_MOD))[(size_t)b * 3072 + n] = s + a.b_ada[n]; }
        __syncthreads();
    }
    for (int tile = blk; tile < 256; tile += gridDim.x) {
        const int g = tile >> 6, k0 = ((tile >> 2) & 15) * 64, n0 = (tile & 3) * 64;
        LAS float* As = (LAS float*)lds;
        LAS float* Bs = (LAS float*)(lds + 65792);
        for (int i = tid; i < 64 * 256; i += NTHREADS) { const int kk = i >> 8, j = i & 255; As[kk * 257 + j] = a.w_in[(size_t)(k0 + kk) * NPROJ + 4096 + g * 256 + j]; }
        for (int i = tid; i < 256 * 64; i += NTHREADS) { const int j = i >> 6, n = i & 63; Bs[j * 64 + n] = a.pool_w[((size_t)g * 256 + j) * 256 + n0 + n]; }
        __syncthreads();
        const int kk = tid >> 3, nn = (tid & 7) * 8;
        f32x4 c0 = {0.f, 0.f, 0.f, 0.f}, c1 = {0.f, 0.f, 0.f, 0.f};
#pragma unroll 4
        for (int j = 0; j < 256; ++j) { const float av = As[kk * 257 + j]; const f32x4 b0 = *(const LAS f32x4*)(Bs + j * 64 + nn), b1 = *(const LAS f32x4*)(Bs + j * 64 + nn + 4); c0 += b0 * av; c1 += b1 * av; }
        bf16_t* WT = (bf16_t*)(a.ws + WS_WIN) + (size_t)(4096 + g * 256 + n0 + nn) * 1024 + k0 + kk;
#pragma unroll
        for (int e = 0; e < 4; ++e) { WT[(size_t)e * 1024] = (bf16_t)f2bf(c0[e]); WT[(size_t)(e + 4) * 1024] = (bf16_t)f2bf(c1[e]); }
        __syncthreads();
    }
    {
        LAS float* scr = (LAS float*)(lds + wave * 16384);
        const int gw = blk * NWAVES + wave, NGW = gridDim.x * NWAVES;
        constexpr int I_IN = (DM / 64) * (NPROJ / 32), I_SQ = (DM / 64) * (DM / 32);
        for (int it = gw; it < I_IN + 3 * I_SQ; it += NGW) {
            int r = it;
            if (r < I_IN) { const int nb = r % (NPROJ / 32); if (nb < 128 || nb >= 160) p0_transpose_item(a.w_in, DM, NPROJ, (bf16_t*)(a.ws + WS_WIN), 0, scr, r, lane); continue; } r -= I_IN;
            if (r < I_SQ) { p0_transpose_item(a.w_a, DM, DM, (bf16_t*)(a.ws + WS_WA), 0, scr, r, lane); continue; } r -= I_SQ;
            if (r < I_SQ) { p0_transpose_item(a.w_b, DM, DM, (bf16_t*)(a.ws + WS_WB), 0, scr, r, lane); continue; } r -= I_SQ;
            p0_transpose_item(a.w_out, DM, DM, (bf16_t*)(a.ws + WS_WO), 0, scr, r, lane);
        }
    }
}

__device__ __forceinline__ void p1_prenorm(const Args& a, int lane, int wave) {
    const int gw = blockIdx.x * NWAVES + wave, NGW = gridDim.x * NWAVES;
    bf16_t* H = (bf16_t*)(a.ws + WS_H);
    for (int rb = gw; rb < MTOK / 32; rb += NGW) {
        const int b = rb >> 6; const float* mod = (const float*)(a.ws + WS_MOD) + (size_t)b * 3072;
        f32x4 ca[4], cs[4];
#pragma unroll
        for (int j = 0; j < 4; ++j) { const int c = 4 * lane + 256 * j; const f32x4 g = *(const f32x4*)(a.norm_gain + c), sc = *(const f32x4*)(mod + 1024 + c); ca[j] = g * (sc + 1.0f); cs[j] = *(const f32x4*)(mod + c); }
#pragma unroll 2
        for (int r = 0; r < 32; ++r) { const size_t row = (size_t)rb * 32 + r; const f32x4* xr = (const f32x4*)(a.x + row * DM) + lane;
            f32x4 v[4]; float s = 0.f;
#pragma unroll
            for (int j = 0; j < 4; ++j) { v[j] = xr[64 * j]; s += (v[j].x * v[j].x + v[j].y * v[j].y) + (v[j].z * v[j].z + v[j].w * v[j].w); }
            const float rstd = 1.0f / sqrtf(wave_sum(s) * (1.0f / DM) + EPS);
            u32x2* o8 = (u32x2*)(H + row * DM) + lane;
#pragma unroll
            for (int j = 0; j < 4; ++j) { const f32x4 o = v[j] * rstd * ca[j] + cs[j]; u32x2 w; w.x = cvt_pk_bf16(o.x, o.y); w.y = cvt_pk_bf16(o.z, o.w); o8[64 * j] = w; } }
    }
}
__device__ __forceinline__ void p6_final_norm(const Args& a, int lane, int wave) {
    const int gw = blockIdx.x * NWAVES + wave, NGW = gridDim.x * NWAVES;
    f32x4 fg[4];
#pragma unroll
    for (int j = 0; j < 4; ++j) fg[j] = *(const f32x4*)(a.final_gain + 4 * lane + 256 * j);
    for (int rb = gw; rb < MTOK / 32; rb += NGW) {
#pragma unroll 2
        for (int r = 0; r < 32; ++r) { const size_t row = (size_t)rb * 32 + r; f32x4* yr = (f32x4*)(a.out + row * DM) + lane;
            f32x4 v[4]; float s = 0.f;
#pragma unroll
            for (int j = 0; j < 4; ++j) { v[j] = yr[64 * j]; s += (v[j].x * v[j].x + v[j].y * v[j].y) + (v[j].z * v[j].z + v[j].w * v[j].w); }
            const float rstd = 1.0f / sqrtf(wave_sum(s) * (1.0f / DM) + EPS);
#pragma unroll
            for (int j = 0; j < 4; ++j) yr[64 * j] = v[j] * rstd * fg[j]; }
    }
}

__device__ __forceinline__ bf16x8 ldg8(const bf16_t* p) { return *(const bf16x8*)p; }
template <bool MASKED>
__device__ __forceinline__ void attn_tile_math(const f32x4 (&s)[4][2], int ks, int t0, int ql, int fq, float (&rp)[2], bf16x8 (&pf)[2][2]) {
    constexpr float C2 = 0.125f * 1.4426950408889634f;
#pragma unroll
    for (int gq = 0; gq < 2; ++gq) {
        const int t = t0 + 16 * gq + ql;
        float om[16], be[16];
#pragma unroll
        for (int b = 0; b < 4; ++b)
#pragma unroll
            for (int i = 0; i < 4; ++i) { const int e = 4 * b + i;
                const float xs = fminf(s[b][gq][i] * C2, 60.f), ex = __builtin_amdgcn_exp2f(xs), omv = __builtin_amdgcn_rcpf(1.0f + ex);
                if (MASKED) { const int key = ks + 16 * fq + e; const bool valid = (key >= 0) && (key < t); om[e] = valid ? omv : 1.0f; be[e] = valid ? ex * omv : 0.0f; }
                else { om[e] = omv; be[e] = ex * omv; } }
        float sp = 1.0f;
#pragma unroll
        for (int e = 15; e >= 0; --e) { const float tmp = om[e]; om[e] = sp; sp *= tmp; }
        const float T0 = __shfl(sp, ql), T1 = __shfl(sp, ql + 16), T2 = __shfl(sp, ql + 32), T3 = __shfl(sp, ql + 48);
        const float X = (fq < 1 ? T1 : 1.0f) * (fq < 2 ? T2 : 1.0f) * (fq < 3 ? T3 : 1.0f);
        const float f = X * rp[gq];
        rp[gq] *= (T0 * T1) * (T2 * T3);
        float w[16];
#pragma unroll
        for (int e = 0; e < 16; ++e) w[e] = be[e] * (om[e] * f);
#pragma unroll
        for (int hv = 0; hv < 2; ++hv) { u32x4 pw; pw.x = cvt_pk_bf16(w[8 * hv], w[8 * hv + 1]); pw.y = cvt_pk_bf16(w[8 * hv + 2], w[8 * hv + 3]); pw.z = cvt_pk_bf16(w[8 * hv + 4], w[8 * hv + 5]); pw.w = cvt_pk_bf16(w[8 * hv + 6], w[8 * hv + 7]);
            pf[hv][gq] = __builtin_bit_cast(bf16x8, pw); }
        __builtin_amdgcn_sched_barrier(0);
    }
}
__device__ __forceinline__ bf16x8 ldu8(const char* ubase, unsigned voff) { return *(const bf16x8*)(ubase + voff); }
#define ATT_LOADV(ks_) do { _Pragma("unroll") for (int hv = 0; hv < 2; ++hv) { int key0 = (ks_) + 16 * fq + 8 * hv; key0 = key0 < 0 ? 0 : key0; const unsigned vo = vlane + (unsigned)key0 * 2u; \
        _Pragma("unroll") for (int db = 0; db < 4; ++db) vf[db][hv] = ldu8(Vu, vo + db * 65536u); } } while (0)
#define ATT_QK() do { _Pragma("unroll") for (int b = 0; b < 4; ++b) _Pragma("unroll") for (int gq = 0; gq < 2; ++gq) { \
        s[b][gq] = __builtin_amdgcn_mfma_f32_16x16x32_bf16(kf[b][0], qf[gq][0], (f32x4){0.f, 0.f, 0.f, 0.f}, 0, 0, 0); \
        s[b][gq] = __builtin_amdgcn_mfma_f32_16x16x32_bf16(kf[b][1], qf[gq][1], s[b][gq], 0, 0, 0); } } while (0)
#define ATT_PV() do { _Pragma("unroll") for (int db = 0; db < 4; ++db) _Pragma("unroll") for (int gq = 0; gq < 2; ++gq) { \
        o[db][gq] = __builtin_amdgcn_mfma_f32_16x16x32_bf16(vf[db][0], pf[0][gq], o[db][gq], 0, 0, 0); \
        o[db][gq] = __builtin_amdgcn_mfma_f32_16x16x32_bf16(vf[db][1], pf[1][gq], o[db][gq], 0, 0, 0); } } while (0)
#define ATT_KPREF(ku_, ks_, slotoff_) do { _Pragma("unroll") for (int b = 0; b < 4; ++b) { int key = (ks_) + kperm + 4 * b; key = key < 0 ? 0 : key; const unsigned ko = (unsigned)key * 2048u + klane; \
        _Pragma("unroll") for (int kh = 0; kh < 2; ++kh) __builtin_amdgcn_global_load_lds((const unsigned*)((ku_) + ko + kh * 64), (LAS unsigned*)(wlds + (slotoff_) + (b * 2 + kh) * 1024), 16, 0, 0); } } while (0)
#define ATT_QPREF(qu_, slotoff_) do { _Pragma("unroll") for (int gq = 0; gq < 2; ++gq) _Pragma("unroll") for (int kh = 0; kh < 2; ++kh) \
        __builtin_amdgcn_global_load_lds((const unsigned*)((qu_) + qlane + gq * 32768u + kh * 64), (LAS unsigned*)(wlds + (slotoff_) + (gq * 2 + kh) * 1024), 16, 0, 0); } while (0)
#define ATT_ZPREF(zu_, slotoff_) do { _Pragma("unroll") for (int p = 0; p < 4; ++p) \
        __builtin_amdgcn_global_load_lds((const unsigned*)((zu_) + zlane + p * 16384u), (LAS unsigned*)(wlds + (slotoff_) + 4096 + p * 1024), 16, 0, 0); } while (0)
__device__ __forceinline__ void attn_wave(const bf16_t* __restrict__ Q, const bf16_t* __restrict__ K, const bf16_t* __restrict__ VT, const bf16_t* __restrict__ ZA, bf16_t* __restrict__ AG,
                                          LAS unsigned char* wlds, int gw, int NGW, int lane_in) {
    int lane = lane_in; asm volatile("" : "+v"(lane));
    constexpr int NU = BPC * NH * 64;
    constexpr float THR = 3.5527136788005009e-15f;
    const int ql = lane & 15, fq = lane >> 4, kperm = 16 * (ql >> 2) + (ql & 3);
    const unsigned klane = 16u * fq, vlane = 4096u * ql, qlane = 2048u * ql + 16u * fq, zlane = 2048u * (lane >> 3) + 16u * (lane & 7), olane = 2048u * ql + 8u * fq;
    int U = gw; if (U >= NU) return;
    int slot = 0;
    { const int bh = U >> 6, t0 = (U & 63) * 32; const size_t rowbase = (size_t)(bh >> 4) * SEQ; const int h = bh & 15;
      const char* Ku = (const char*)(K + rowbase * DM + h * 64); ATT_KPREF(Ku, t0 - 32, 0);
      const char* Qu = (const char*)(Q + (rowbase + t0) * DM + h * 64); ATT_QPREF(Qu, 8192); }
    for (; U < NU; U += NGW) {
        const int bh = U >> 6, t0 = (U & 63) * 32, bl = bh >> 4, h = bh & 15;
        const size_t rowbase = (size_t)bl * SEQ;
        const char* Ku = (const char*)(K + rowbase * DM + h * 64);
        const char* Vu = (const char*)(VT + ((size_t)bl * DM + h * 64) * SEQ);
        const int np = (t0 >= 64) ? 2 : 1;
        const int Un = U + NGW; const bool has_next = Un < NU;
        f32x4 o[4][2];
#pragma unroll
        for (int db = 0; db < 4; ++db) { o[db][0] = (f32x4){0.f, 0.f, 0.f, 0.f}; o[db][1] = (f32x4){0.f, 0.f, 0.f, 0.f}; }
        float rp[2] = {1.f, 1.f};
        bf16x8 qf[2][2];
        asm volatile("s_waitcnt vmcnt(0)" ::: "memory");
        { const LAS unsigned char* qp_ = wlds + (slot ^ 1) * 8192 + lane * 16;
#pragma unroll
          for (int gq = 0; gq < 2; ++gq)
#pragma unroll
              for (int kh = 0; kh < 2; ++kh) qf[gq][kh] = *(const LAS bf16x8*)(qp_ + (gq * 2 + kh) * 1024); }
        asm volatile("s_waitcnt lgkmcnt(0)" ::: "memory");
        for (int jt = 0; jt < np; ++jt) {
            const int ks = t0 - 32 - 64 * jt;
            bf16x8 kf[4][2], vf[4][2], pf[2][2]; f32x4 s[4][2];
            asm volatile("s_waitcnt vmcnt(0)" ::: "memory");
            { const LAS unsigned char* sp_ = wlds + slot * 8192 + lane * 16;
#pragma unroll
              for (int b = 0; b < 4; ++b)
#pragma unroll
                  for (int kh = 0; kh < 2; ++kh) kf[b][kh] = *(const LAS bf16x8*)(sp_ + (b * 2 + kh) * 1024); }
            asm volatile("s_waitcnt lgkmcnt(0)" ::: "memory");
            ATT_LOADV(ks);
            if (jt + 1 < np) { ATT_KPREF(Ku, ks - 64, (slot ^ 1) * 8192); }
            else {
                if (has_next) { const int bhn = Un >> 6, t0n = (Un & 63) * 32, hn = bhn & 15; const size_t rbn = (size_t)(bhn >> 4) * SEQ;
                    const char* Kun = (const char*)(K + rbn * DM + hn * 64); ATT_KPREF(Kun, t0n - 32, (slot ^ 1) * 8192);
                    const char* Qun = (const char*)(Q + (rbn + t0n) * DM + hn * 64); ATT_QPREF(Qun, slot * 8192); }
                { const char* Zu = (const char*)(ZA + (rowbase + t0) * DM + h * 64); ATT_ZPREF(Zu, slot * 8192); }
            }
            ATT_QK();
            if (jt == 0 || ks < 0) attn_tile_math<true>(s, ks, t0, ql, fq, rp, pf); else attn_tile_math<false>(s, ks, t0, ql, fq, rp, pf);
            ATT_PV();
            slot ^= 1;
        }
        for (int jt = np;; ++jt) {
            const int ks = t0 - 32 - 64 * jt;
            if (ks + 64 <= 0) break;
            if (__all(fmaxf(rp[0], rp[1]) < THR)) break;
            bf16x8 kf[4][2], vf[4][2], pf[2][2]; f32x4 s[4][2];
#pragma unroll
            for (int b = 0; b < 4; ++b) { int key = ks + kperm + 4 * b; key = key < 0 ? 0 : key; const unsigned ko = (unsigned)key * 2048u + klane;
#pragma unroll
                for (int kh = 0; kh < 2; ++kh) kf[b][kh] = ldu8(Ku, ko + kh * 64); }
            ATT_LOADV(ks);
            ATT_QK();
            attn_tile_math<true>(s, ks, t0, ql, fq, rp, pf);
            ATT_PV();
        }
        asm volatile("s_waitcnt vmcnt(0)" ::: "memory");
        const LAS unsigned char* zl_ = wlds + (slot ^ 1) * 8192 + 4096 + ql * 128 + fq * 8;
        char* Au = (char*)(AG + (rowbase + t0) * DM + h * 64);
#pragma unroll
        for (int gq = 0; gq < 2; ++gq)
#pragma unroll
            for (int db = 0; db < 4; ++db) {
                const u32x2 z = *(const LAS u32x2*)(zl_ + gq * 2048 + db * 32); const f32x4 ov = o[db][gq];
                u32x2 w; w.x = cvt_pk_bf16(ov[0] * bf_lo(z.x), ov[1] * bf_hi(z.x)); w.y = cvt_pk_bf16(ov[2] * bf_lo(z.y), ov[3] * bf_hi(z.y));
                *(u32x2*)(Au + olane + gq * 32768u + db * 32) = w; }
        asm volatile("s_waitcnt lgkmcnt(0)" ::: "memory");
    }
    asm volatile("s_waitcnt vmcnt(0)" ::: "memory");
}
struct f32x8_t { f32x4 lo, hi; };
__device__ __forceinline__ f32x8_t ld8bf(const bf16_t* p) { const u32x4 w = *(const u32x4*)p; f32x8_t r; r.lo = (f32x4){bf_lo(w.x), bf_hi(w.x), bf_lo(w.y), bf_hi(w.y)}; r.hi = (f32x4){bf_lo(w.z), bf_hi(w.z), bf_lo(w.w), bf_hi(w.w)}; return r; }
__device__ __forceinline__ void pool_wave(const bf16_t* __restrict__ Y, const bf16_t* __restrict__ ZB, const float* __restrict__ pscale, bf16_t* __restrict__ BG, int gw, int NGW, int lane_in) {
    int lane = lane_in; asm volatile("" : "+v"(lane));
    for (int U = gw; U < BPC * 2 * 64; U += NGW) {
        const int bl = U >> 7, half = (U >> 6) & 1, t0 = (U & 63) * 32;
        const int ch = half * 512 + lane * 8, win = 2 << (2 * half + (lane >> 5));
        const size_t base = (size_t)bl * SEQ * DM + ch;
        const f32x4 ps0 = *(const f32x4*)(pscale + ch), ps1 = *(const f32x4*)(pscale + ch + 4);
        const float rwin = 1.0f / (float)win;
        f32x4 r0 = {0.f, 0.f, 0.f, 0.f}, r1 = {0.f, 0.f, 0.f, 0.f};
        if (t0 > 0) {
#pragma unroll
            for (int i = 0; i < 16; ++i) { const int tt = t0 - 16 + i; const f32x8_t v = ld8bf(Y + base + (size_t)tt * DM); const float m = (tt >= t0 - win) ? 1.0f : 0.0f; r0 += v.lo * m; r1 += v.hi * m; }
        }
#pragma unroll 4
        for (int t = t0; t < t0 + 32; ++t) {
            const int tp = t - win; const float mo = tp >= 0 ? 1.0f : 0.0f;
            const f32x8_t yv = ld8bf(Y + base + (size_t)t * DM), zb = ld8bf(ZB + base + (size_t)t * DM), yo = ld8bf(Y + base + (size_t)(tp < 0 ? 0 : tp) * DM);
            r0 += yv.lo - yo.lo * mo; r1 += yv.hi - yo.hi * mo;
            const float rc = (t + 1 < win) ? __builtin_amdgcn_rcpf((float)(t + 1)) : rwin;
            const f32x4 o0 = (r0 * rc - yv.lo) * ps0 * zb.lo, o1 = (r1 * rc - yv.hi) * ps1 * zb.hi;
            u32x4 w; w.x = cvt_pk_bf16(o0[0], o0[1]); w.y = cvt_pk_bf16(o0[2], o0[3]); w.z = cvt_pk_bf16(o1[0], o1[1]); w.w = cvt_pk_bf16(o1[2], o1[3]);
            *(u32x4*)(BG + base + (size_t)t * DM) = w;
        }
    }
}

__global__ void __launch_bounds__(NTHREADS) hybrid_fwd(Args a) {
    extern __shared__ __attribute__((aligned(16))) unsigned char lds_raw[];
    LAS unsigned char* lds = (LAS unsigned char*)lds_raw;
    cg::grid_group grid = cg::this_grid();
    const int tid = threadIdx.x, lane = tid & 63, wave = __builtin_amdgcn_readfirstlane(tid >> 6);
    const int G = gridDim.x;
    unsigned char* ws = a.ws;
    bf16_t* H = (bf16_t*)(ws + WS_H); bf16_t* PROJ = (bf16_t*)(ws + WS_PROJ);
    bf16_t* AGb = (bf16_t*)(ws + WS_AG); bf16_t* BGb = (bf16_t*)(ws + WS_BG); bf16_t* MG = (bf16_t*)(ws + WS_MG);
    const bf16_t* WIN = (const bf16_t*)(ws + WS_WIN); const bf16_t* WA = (const bf16_t*)(ws + WS_WA); const bf16_t* WB = (const bf16_t*)(ws + WS_WB); const bf16_t* WO = (const bf16_t*)(ws + WS_WO);

    volatile LAS unsigned* MISC = (volatile LAS unsigned*)(lds + MISC_OFF);
    if (tid < 64) MISC[tid] = 0u;
    __syncthreads();
    if (a.ws == nullptr) grid.sync();
    const XcdBarrier bar = xcd_barrier_post((unsigned*)ws, MISC + 8);
#define GRID_BAR() xcd_barrier(bar)
    p0_prologue(a, lds, tid, lane, wave);
    GRID_BAR();
    p1_prenorm(a, lane, wave);
    GRID_BAR();
    for (int ch = 0; ch < NCHUNK; ++ch) {
        { pg8::Gemm g{H + (size_t)ch * MC * DM, nullptr, WIN, nullptr, MC, NPROJ, DM}; pg8::StaticOrder S; S.init(MC, NPROJ, G, (int)blockIdx.x, 0);
          pg8::EpiProj E{PROJ}; pg8::gemm_phase<pg8::EpiProj, true, true>(lds, g, S, E); }
        GRID_BAR();
        { const int gw = blockIdx.x * NWAVES + wave, NGW = G * NWAVES;
          const bf16_t* Qb = PROJ; const bf16_t* Kb = PROJ + pg8::SEG_ELEMS; const bf16_t* VTb = PROJ + 2 * pg8::SEG_ELEMS; const bf16_t* ZAb = PROJ + 3 * pg8::SEG_ELEMS;
          const bf16_t* Yb = PROJ + 4 * pg8::SEG_ELEMS; const bf16_t* ZBb = PROJ + 5 * pg8::SEG_ELEMS;
          if (wave < 4) pool_wave(Yb, ZBb, a.pool_scale, BGb, gw, NGW, lane);
          attn_wave(Qb, Kb, VTb, ZAb, AGb, lds + wave * 16384, gw, NGW, lane);
          if (wave >= 4) pool_wave(Yb, ZBb, a.pool_scale, BGb, gw, NGW, lane); }
        GRID_BAR();
        { pg8::Gemm g{AGb, BGb, WA, WB, MC, DM, DM}; pg8::StaticOrder S; S.init(MC, DM, G, (int)blockIdx.x, 1);
          pg8::EpiMerge E{PROJ + 6 * pg8::SEG_ELEMS, PROJ + 7 * pg8::SEG_ELEMS, MG}; pg8::gemm_phase<pg8::EpiMerge, true, true>(lds, g, S, E); }
        GRID_BAR();
        { pg8::Gemm g{MG, nullptr, WO, nullptr, MC, DM, DM}; pg8::StaticOrder S; S.init(MC, DM, G, (int)blockIdx.x, 0);
          pg8::EpiOut E{a.x, (const float*)(ws + WS_MOD), a.out, ch * MC}; pg8::gemm_phase<pg8::EpiOut, true, true>(lds, g, S, E); }
    }
    GRID_BAR();
    p6_final_norm(a, lane, wave);
}

extern "C" void kernel_launch(void* const* d_in, const int* in_sizes, int n_in, void* d_out, int out_size, void* d_ws, size_t ws_size, hipStream_t stream) {
    static int grid = 0;
    if (grid == 0) {
        if (n_in != 12 || in_sizes[0] != MTOK * DM || out_size != MTOK * DM || ws_size < WS_END) { fprintf(stderr, "kernel_launch: unexpected shapes (n_in %d, in0 %d, out %d, ws %zu)\n", n_in, n_in > 0 ? in_sizes[0] : -1, out_size, ws_size); grid = -1; return; }
        int dev = 0, cus = 0, per_cu = 0;
        if (hipGetDevice(&dev) != hipSuccess || hipDeviceGetAttribute(&cus, hipDeviceAttributeMultiprocessorCount, dev) != hipSuccess) { grid = -1; return; }
        if (hipFuncSetAttribute((const void*)hybrid_fwd, hipFuncAttributeMaxDynamicSharedMemorySize, LDS_BYTES) != hipSuccess) { fprintf(stderr, "kernel_launch: hipFuncSetAttribute failed\n"); grid = -1; return; }
        if (hipOccupancyMaxActiveBlocksPerMultiprocessor(&per_cu, (const void*)hybrid_fwd, NTHREADS, LDS_BYTES) != hipSuccess || per_cu < 1) { fprintf(stderr, "kernel_launch: occupancy query says %d\n", per_cu); per_cu = 1; }
        (void)hipGetLastError();
        grid = cus;
    }
    if (grid < 0) return;
    Args a{};
    a.x = (const float*)d_in[0]; a.c = (const float*)d_in[1]; a.norm_gain = (const float*)d_in[2]; a.w_ada = (const float*)d_in[3]; a.b_ada = (const float*)d_in[4];
    a.w_in = (const float*)d_in[5]; a.pool_w = (const float*)d_in[6]; a.pool_scale = (const float*)d_in[7]; a.w_a = (const float*)d_in[8]; a.w_b = (const float*)d_in[9];
    a.w_out = (const float*)d_in[10]; a.final_gain = (const float*)d_in[11]; a.out = (float*)d_out; a.ws = (unsigned char*)d_ws;
    if (hipMemsetAsync(d_ws, 0, 65536, stream) != hipSuccess) { fprintf(stderr, "kernel_launch: memset failed\n"); return; }
    void* args[] = {&a};
    hipError_t e = hipLaunchCooperativeKernel((const void*)hybrid_fwd, dim3(grid), dim3(NTHREADS), args, LDS_BYTES, stream);
    if (e != hipSuccess) fprintf(stderr, "kernel_launch: cooperative launch failed: %s (grid %d)\n", hipGetErrorString(e), grid);
}
```

```cpp
#include <hip/hip_runtime.h>
#include <hip/hip_cooperative_groups.h>
#include <cstdio>
#include <cstdint>
namespace cg = cooperative_groups;

namespace pg8 {
#define PG8_LAS __attribute__((address_space(3)))
typedef unsigned short bf16_t;
typedef short bf16x8 __attribute__((ext_vector_type(8)));
typedef float f32x4 __attribute__((ext_vector_type(4)));
typedef unsigned u32x4 __attribute__((ext_vector_type(4)));
typedef unsigned u32x2 __attribute__((ext_vector_type(2)));
constexpr int BM = 256, BK = 64, HALF = 128, HTB = HALF * BK * 2  , STAGE_BYTES = 8 * HTB, NXCD = 8, WGM = 8;

__host__ __device__ __forceinline__ int lds_byte(int r, int c) { const int st = (r >> 4) * 2 + (c >> 5), rr = r & 15, cc = c & 31, ob = rr * 64 + cc * 2; return st * 1024 + (ob ^ (((ob >> 9) & 1) << 5)); }
__host__ __device__ __forceinline__ void stage_rc(int b, int& R, int& C) { const int st = b / 1024, sb = b % 1024, swz = sb ^ (((sb >> 9) & 1) << 5); R = (st >> 1) * 16 + swz / 64; C = (st & 1) * 32 + (swz % 64) / 2; }
__host__ __device__ __forceinline__ int perm32(int rho) { const int n = rho >> 4, i = rho & 15; return 8 * (i >> 2) + 4 * n + (i & 3); }

struct Unit { int pm, pn, sel; };
struct Gemm { const bf16_t* A0; const bf16_t* A1; const bf16_t* B0; const bf16_t* B1; int M, N, K; };

struct StaticOrder {
    int nM, nN, nwg, G, c, pair;
    __host__ __device__ void init(int M, int N, int G_, int c_, int pair_) { nM = M / BM; nN = N / BM; nwg = nM * nN; G = G_; c = c_; pair = pair_; }
    __host__ __device__ bool next(int ii, Unit& u) const {
        const int i = pair ? (ii >> 1) : ii; u.sel = pair ? (ii & 1) : 0;
        const long L = (long)i * G + c; if (L >= nwg) return false;
        int wgid = (int)L; { const int q = nwg / NXCD, r = nwg % NXCD, xcd = wgid % NXCD, off = wgid / NXCD; wgid = (xcd < r ? xcd * (q + 1) : r * (q + 1) + (xcd - r) * q) + off; }
        const int nig = WGM * nN, gid = wgid / nig, fm = gid * WGM, gsz = (nM - fm) < WGM ? (nM - fm) : WGM;
        u.pm = fm + ((wgid % nig) % gsz); u.pn = (wgid % nig) / gsz; return true;
    }
};

__device__ __forceinline__ unsigned cvt_pk_bf16(float lo, float hi) { unsigned r; asm("v_cvt_pk_bf16_f32 %0, %1, %2" : "=v"(r) : "v"(lo), "v"(hi)); return r; }
__device__ __forceinline__ float bf_lo(unsigned w) { return __uint_as_float(w << 16); }
__device__ __forceinline__ float bf_hi(unsigned w) { return __uint_as_float(w & 0xffff0000u); }
__device__ __forceinline__ float fast_sigmoid(float x) { return __builtin_amdgcn_rcpf(1.0f + __expf(-x)); }

constexpr int PROJ_ROWS = 32768;
constexpr size_t SEG_ELEMS = (size_t)PROJ_ROWS * 1024;
struct EpiProj {
    static constexpr bool PERM = true, PAIR = false;
    bf16_t* P;
    __device__ __forceinline__ void operator()(f32x4 (&acc)[2][2][4][2], const Unit& u, int wr, int wc, int fr, int fq) const {
        const int sg = u.pn >> 2, colt = (u.pn & 3) * BM;
        const int row0 = u.pm * BM + wr * 64 + fr, col0 = colt + wc * 32 + 8 * fq;
        bf16_t* base = P + (size_t)sg * SEG_ELEMS;
        if (sg == 2) {
#pragma unroll
            for (int ai = 0; ai < 2; ++ai)
#pragma unroll
                for (int m = 0; m < 4; ++m) { const int r = row0 + ai * HALF + m * 16; bf16_t* vp = base + ((size_t)(r >> 11) * 1024 + col0) * 2048 + (r & 2047);
#pragma unroll
                    for (int bj = 0; bj < 2; ++bj)
#pragma unroll
                        for (int n = 0; n < 2; ++n)
#pragma unroll
                            for (int j = 0; j < 4; ++j) { const float v = acc[ai][bj][m][n][j]; vp[(size_t)(bj * HALF + 4 * n + j) * 2048] = (bf16_t)(cvt_pk_bf16(v, v) & 0xffffu); } }
        } else {
            const int act = (sg == 3 || sg == 5) ? 1 : (sg >= 6 ? 2 : 0);
#pragma unroll
            for (int ai = 0; ai < 2; ++ai)
#pragma unroll
                for (int m = 0; m < 4; ++m) { bf16_t* rowp = base + (size_t)(row0 + ai * HALF + m * 16) * 1024 + col0;
#pragma unroll
                    for (int bj = 0; bj < 2; ++bj) { f32x4 v0 = acc[ai][bj][m][0], v1 = acc[ai][bj][m][1];
                        if (act) {
#pragma unroll
                            for (int j = 0; j < 4; ++j) { const float s0 = fast_sigmoid(v0[j]), s1 = fast_sigmoid(v1[j]); v0[j] = (act == 1) ? v0[j] * s0 : s0; v1[j] = (act == 1) ? v1[j] * s1 : s1; } }
                        u32x4 w; w.x = cvt_pk_bf16(v0[0], v0[1]); w.y = cvt_pk_bf16(v0[2], v0[3]); w.z = cvt_pk_bf16(v1[0], v1[1]); w.w = cvt_pk_bf16(v1[2], v1[3]);
                        *(u32x4*)(rowp + bj * HALF) = w; } }
        }
    }
};
struct EpiMerge {
    static constexpr bool PERM = true, PAIR = true;
    const bf16_t* SA; const bf16_t* SB; bf16_t* O;
    __device__ __forceinline__ void operator()(f32x4 (&acc)[2][2][4][2], const Unit& u, int wr, int wc, int fr, int fq) const {
        const int row0 = u.pm * BM + wr * 64 + fr, col0 = u.pn * BM + wc * 32 + 8 * fq;
#pragma unroll
        for (int ai = 0; ai < 2; ++ai)
#pragma unroll
            for (int m = 0; m < 4; ++m) { const size_t off = (size_t)(row0 + ai * HALF + m * 16) * 1024 + col0;
#pragma unroll
                for (int bj = 0; bj < 2; ++bj) {
                    const u32x4 sbw = *(const u32x4*)(SB + off + bj * HALF);
                    float sb[8];
#pragma unroll
                    for (int j = 0; j < 4; ++j) { sb[2 * j] = fmaxf(bf_lo(sbw[j]), 1e-30f); sb[2 * j + 1] = fmaxf(bf_hi(sbw[j]), 1e-30f); }
                    if (u.sel == 0) {
                        const u32x4 saw = *(const u32x4*)(SA + off + bj * HALF);
#pragma unroll
                        for (int j = 0; j < 4; ++j) { const float r0 = bf_lo(saw[j]) * __builtin_amdgcn_rcpf(sb[2 * j]), r1 = bf_hi(saw[j]) * __builtin_amdgcn_rcpf(sb[2 * j + 1]);
                            if (j < 2) { acc[ai][bj][m][0][2 * j] *= r0; acc[ai][bj][m][0][2 * j + 1] *= r1; } else { acc[ai][bj][m][1][2 * j - 4] *= r0; acc[ai][bj][m][1][2 * j - 3] *= r1; } }
                    } else {
                        const f32x4 v0 = acc[ai][bj][m][0], v1 = acc[ai][bj][m][1];
                        u32x4 w; w.x = cvt_pk_bf16(v0[0] * sb[0], v0[1] * sb[1]); w.y = cvt_pk_bf16(v0[2] * sb[2], v0[3] * sb[3]); w.z = cvt_pk_bf16(v1[0] * sb[4], v1[1] * sb[5]); w.w = cvt_pk_bf16(v1[2] * sb[6], v1[3] * sb[7]);
                        *(u32x4*)(O + off + bj * HALF) = w; } } }
    }
};
struct EpiOut {
    static constexpr bool PERM = false, PAIR = false;
    const float* x; const float* mod; float* out; int row_off;
    __device__ __forceinline__ void operator()(f32x4 (&acc)[2][2][4][2], const Unit& u, int wr, int wc, int fr, int fq) const {
        const int R0 = row_off + u.pm * BM + wr * 64 + fr, col0 = u.pn * BM + wc * 32 + 4 * fq;
        const float* gate = mod + (size_t)((row_off + u.pm * BM) >> 11) * 3072 + 2048;
        f32x4 gv[2][2];
#pragma unroll
        for (int bj = 0; bj < 2; ++bj)
#pragma unroll
            for (int n = 0; n < 2; ++n) gv[bj][n] = *(const f32x4*)(gate + col0 + bj * HALF + n * 16);
#pragma unroll
        for (int ai = 0; ai < 2; ++ai)
#pragma unroll
            for (int m = 0; m < 4; ++m) { const size_t off = (size_t)(R0 + ai * HALF + m * 16) * 1024 + col0;
#pragma unroll
                for (int bj = 0; bj < 2; ++bj)
#pragma unroll
                    for (int n = 0; n < 2; ++n) { const f32x4 xv = *(const f32x4*)(x + off + bj * HALF + n * 16); *(f32x4*)(out + off + bj * HALF + n * 16) = xv + gv[bj][n] * acc[ai][bj][m][n]; } }
    }
};

template <class Epi, bool ALIGN_EPI, bool SP2>
__device__ __forceinline__ void gemm_phase(PG8_LAS unsigned char* lds, const Gemm g, const StaticOrder& S, const Epi& E) {
    int tid_l = threadIdx.x; asm volatile("" : "+v"(tid_l));
    const int tid = tid_l, wid = __builtin_amdgcn_readfirstlane(tid >> 6), lane = tid & 63, wr = wid >> 2, wc = wid & 3, fr = lane & 15, fq = lane >> 4;
    const int K = g.K, nt = K / BK;
    unsigned voffA[2], voffB[2];
#pragma unroll
    for (int i = 0; i < 2; ++i) { int R, C; stage_rc(tid * 16 + i * 8192, R, C); const int Rb = Epi::PERM ? ((R & ~31) + perm32(R & 31)) : R;
        voffA[i] = (unsigned)(R * K + C) * 2u; voffB[i] = (unsigned)(Rb * K + C) * 2u; }
    const size_t kstep = (size_t)(BK * 2);
    const size_t hstep = (size_t)HALF * K * 2;
    const size_t tstep = 2 * hstep;
    const unsigned ldsw = (unsigned)wid * 1024u;
    const int aoff = lds_byte(wr * 64 + fr, fq * 8), boff = lds_byte(wc * 32 + fr, fq * 8);
#define PG8_SA(b, h) (((b) * 2 + (h)) * HTB)
#define PG8_SB(b, h) ((4 + (b) * 2 + (h)) * HTB)
#define PG8_STAGE(bufoff, gbase, voff) do { _Pragma("unroll") for (int _i = 0; _i < 2; ++_i) \
        __builtin_amdgcn_global_load_lds((const unsigned*)((const char*)(gbase) + (voff)[_i]), (PG8_LAS unsigned*)(lds + (bufoff) + ldsw + _i * 8192), 16, 0, 0); } while (0)
#define PG8_LDA(dst, b, h) do { _Pragma("unroll") for (int m = 0; m < 4; ++m) _Pragma("unroll") for (int k = 0; k < 2; ++k) dst[m][k] = *(const PG8_LAS bf16x8*)(lds + PG8_SA(b, h) + aoff + m * 2048 + k * 1024); } while (0)
#define PG8_LDB(dst, b, h) do { _Pragma("unroll") for (int n = 0; n < 2; ++n) _Pragma("unroll") for (int k = 0; k < 2; ++k) dst[n][k] = *(const PG8_LAS bf16x8*)(lds + PG8_SB(b, h) + boff + n * 2048 + k * 1024); } while (0)
#define PG8_MMA(ai, bj, At, Bt) do { __builtin_amdgcn_s_setprio(1); _Pragma("unroll") for (int m = 0; m < 4; ++m) _Pragma("unroll") for (int n = 0; n < 2; ++n) _Pragma("unroll") for (int k = 0; k < 2; ++k) \
        acc[ai][bj][m][n] = __builtin_amdgcn_mfma_f32_16x16x32_bf16(Bt[n][k], At[m][k], acc[ai][bj][m][n], 0, 0, 0); __builtin_amdgcn_s_setprio(0); } while (0)
#define PG8_WAIT_V(n) asm volatile("s_waitcnt vmcnt(" #n ")" ::: "memory")
#define PG8_WAIT_L(n) asm volatile("s_waitcnt lgkmcnt(" #n ")" ::: "memory")
#define PG8_BAR __builtin_amdgcn_s_barrier()
#define PG8_SCHED __builtin_amdgcn_sched_barrier(0)
    Unit cur, nxt; int ui = 0;
    if (!S.next(0, cur)) return;
    f32x4 acc[2][2][4][2];
#pragma unroll
    for (int a = 0; a < 2; ++a)
#pragma unroll
        for (int b = 0; b < 2; ++b)
#pragma unroll
            for (int m = 0; m < 4; ++m)
#pragma unroll
                for (int n = 0; n < 2; ++n) acc[a][b][m][n] = (f32x4){0.f, 0.f, 0.f, 0.f};
    bf16x8 At[4][2], B0[2][2], B1[2][2];
    const char* cA = (const char*)(cur.sel ? g.A1 : g.A0) + (size_t)cur.pm * tstep; const char* cB = (const char*)(cur.sel ? g.B1 : g.B0) + (size_t)cur.pn * tstep;
    if constexpr (SP2) {
        PG8_STAGE(PG8_SB(0, 0), cB, voffB); PG8_STAGE(PG8_SB(0, 1), cB + hstep, voffB); PG8_STAGE(PG8_SA(0, 0), cA, voffA); PG8_STAGE(PG8_SA(0, 1), cA + hstep, voffA);
        if (wr == 1) PG8_BAR;
        PG8_WAIT_V(2); PG8_BAR;
        PG8_STAGE(PG8_SB(1, 0), cB + kstep, voffB); PG8_STAGE(PG8_SA(1, 0), cA + kstep, voffA); PG8_STAGE(PG8_SB(1, 1), cB + hstep + kstep, voffB);
        PG8_WAIT_V(6); PG8_BAR;
    } else {
        PG8_STAGE(PG8_SB(0, 0), cB, voffB); PG8_STAGE(PG8_SA(0, 0), cA, voffA); PG8_STAGE(PG8_SB(0, 1), cB + hstep, voffB); PG8_STAGE(PG8_SA(0, 1), cA + hstep, voffA);
        if (wr == 1) PG8_BAR;
        PG8_WAIT_V(4); PG8_BAR;
        PG8_STAGE(PG8_SB(1, 0), cB + kstep, voffB); PG8_STAGE(PG8_SA(1, 0), cA + kstep, voffA); PG8_STAGE(PG8_SB(1, 1), cB + hstep + kstep, voffB);
        PG8_WAIT_V(6); PG8_BAR;
    }
    for (;;) {
        const bool has_next = S.next(ui + 1, nxt);
        const char* nA = has_next ? (const char*)(nxt.sel ? g.A1 : g.A0) + (size_t)nxt.pm * tstep : cA; const char* nB = has_next ? (const char*)(nxt.sel ? g.B1 : g.B0) + (size_t)nxt.pn * tstep : cB;
        for (int t = 0; t < nt; t += 2) {
            const bool last = (t == nt - 2);
            const char* a1 = cA + (size_t)(t + 1) * kstep;
            const char* a2 = last ? nA : cA + (size_t)(t + 2) * kstep; const char* b2 = last ? nB : cB + (size_t)(t + 2) * kstep;
            const char* a3 = a2 + kstep; const char* b3 = b2 + kstep;
            if constexpr (SP2) {
            PG8_LDB(B0, 0, 0); PG8_LDB(B1, 0, 1); PG8_SCHED; PG8_LDA(At, 0, 0); PG8_STAGE(PG8_SA(1, 1), a1 + hstep, voffA);
            PG8_WAIT_V(8); PG8_WAIT_L(0); PG8_BAR; PG8_MMA(0, 0, At, B0); PG8_MMA(0, 1, At, B1); PG8_BAR; PG8_SCHED;
            PG8_LDA(At, 0, 1); PG8_STAGE(PG8_SB(0, 0), b2, voffB); PG8_STAGE(PG8_SB(0, 1), b2 + hstep, voffB); PG8_STAGE(PG8_SA(0, 0), a2, voffA);
            PG8_WAIT_V(8); PG8_WAIT_L(0); PG8_BAR; PG8_MMA(1, 0, At, B0); PG8_MMA(1, 1, At, B1); PG8_BAR; PG8_SCHED;
            PG8_LDB(B0, 1, 0); PG8_LDB(B1, 1, 1); PG8_SCHED; PG8_LDA(At, 1, 0); PG8_STAGE(PG8_SA(0, 1), a2 + hstep, voffA);
            PG8_WAIT_V(8); PG8_WAIT_L(0); PG8_BAR; PG8_MMA(0, 0, At, B0); PG8_MMA(0, 1, At, B1); PG8_BAR; PG8_SCHED;
            PG8_LDA(At, 1, 1); PG8_STAGE(PG8_SB(1, 0), b3, voffB); PG8_STAGE(PG8_SB(1, 1), b3 + hstep, voffB); PG8_STAGE(PG8_SA(1, 0), a3, voffA);
            PG8_WAIT_V(8); PG8_WAIT_L(0); PG8_BAR; PG8_MMA(1, 0, At, B0); PG8_MMA(1, 1, At, B1); PG8_BAR; PG8_SCHED;
            } else {
            PG8_LDB(B0, 0, 0); PG8_SCHED; PG8_LDA(At, 0, 0); PG8_STAGE(PG8_SA(1, 1), a1 + hstep, voffA);
            PG8_WAIT_L(8); PG8_BAR; PG8_WAIT_L(0); PG8_MMA(0, 0, At, B0); PG8_BAR; PG8_SCHED;
            PG8_LDB(B1, 0, 1); PG8_STAGE(PG8_SB(0, 0), b2, voffB);
            PG8_BAR; PG8_WAIT_L(0); PG8_MMA(0, 1, At, B1); PG8_BAR;
            PG8_LDA(At, 0, 1); PG8_STAGE(PG8_SA(0, 0), a2, voffA);
            PG8_BAR; PG8_WAIT_L(0); PG8_MMA(1, 0, At, B0); PG8_BAR; PG8_SCHED;
            PG8_STAGE(PG8_SB(0, 1), b2 + hstep, voffB);
            PG8_WAIT_V(6); PG8_BAR; PG8_MMA(1, 1, At, B1); PG8_BAR;
            PG8_LDB(B0, 1, 0); PG8_SCHED; PG8_LDA(At, 1, 0); PG8_STAGE(PG8_SA(0, 1), a2 + hstep, voffA);
            PG8_WAIT_L(8); PG8_BAR; PG8_WAIT_L(0); PG8_MMA(0, 0, At, B0); PG8_BAR; PG8_SCHED;
            PG8_LDB(B1, 1, 1); PG8_STAGE(PG8_SB(1, 0), b3, voffB);
            PG8_BAR; PG8_WAIT_L(0); PG8_MMA(0, 1, At, B1); PG8_BAR;
            PG8_LDA(At, 1, 1); PG8_STAGE(PG8_SA(1, 0), a3, voffA);
            PG8_BAR; PG8_WAIT_L(0); PG8_MMA(1, 0, At, B0); PG8_BAR; PG8_SCHED;
            PG8_STAGE(PG8_SB(1, 1), b3 + hstep, voffB);
            PG8_WAIT_V(6); PG8_BAR; PG8_MMA(1, 1, At, B1); PG8_BAR;
            }
        }
        if constexpr (ALIGN_EPI) { if (wr == 0) PG8_BAR; }
        E(acc, cur, wr, wc, fr, fq);
        if (!has_next) break;
        if (!(Epi::PAIR && cur.sel == 0))
#pragma unroll
        for (int a = 0; a < 2; ++a)
#pragma unroll
            for (int b = 0; b < 2; ++b)
#pragma unroll
                for (int m = 0; m < 4; ++m)
#pragma unroll
                    for (int n = 0; n < 2; ++n) acc[a][b][m][n] = (f32x4){0.f, 0.f, 0.f, 0.f};
        cur = nxt; cA = nA; cB = nB; ++ui;
        if constexpr (ALIGN_EPI) { if (wr == 1) PG8_BAR; }
    }
    PG8_WAIT_V(0);
    if constexpr (!ALIGN_EPI) { if (wr == 0) PG8_BAR; }
    PG8_BAR;
#undef PG8_SA
#undef PG8_SB
#undef PG8_STAGE
#undef PG8_LDA
#undef PG8_LDB
#undef PG8_MMA
#undef PG8_WAIT_V
#undef PG8_WAIT_L
#undef PG8_BAR
#undef PG8_SCHED
}
}

#define LAS __attribute__((address_space(3)))
using pg8::bf16_t; using pg8::bf16x8; using pg8::f32x4; using pg8::u32x4; using pg8::u32x2; using pg8::cvt_pk_bf16; using pg8::bf_lo; using pg8::bf_hi;
constexpr int NB = 32, SEQ = 2048, DM = 1024, MTOK = NB * SEQ, NPROJ = 8192, NH = 16;
constexpr int NCHUNK = 2, MC = MTOK / NCHUNK, BPC = NB / NCHUNK;
static_assert(MC == pg8::PROJ_ROWS, "chunk rows");
constexpr float EPS = 1e-6f;
constexpr int NWAVES = 8, NTHREADS = 512, MISC_OFF = 147456, LDS_BYTES = MISC_OFF + 256;
constexpr size_t MiB = 1u << 20;
constexpr size_t WS_MOD = 1 * MiB;
constexpr size_t WS_WIN = 2 * MiB;
constexpr size_t WS_WA = 18 * MiB, WS_WB = 20 * MiB, WS_WO = 22 * MiB;
constexpr size_t WS_H = 24 * MiB;
constexpr size_t WS_PROJ = 152 * MiB;
constexpr size_t WS_AG = 664 * MiB, WS_BG = 728 * MiB, WS_MG = 792 * MiB, WS_END = 856 * MiB;

__device__ __forceinline__ float wave_sum(float v) {
#pragma unroll
    for (int o = 1; o < 64; o <<= 1) v += __shfl_xor(v, o);
    return v;
}
__device__ __forceinline__ unsigned f2bf(float f) { unsigned u = __builtin_bit_cast(unsigned, f); return (u + 0x7fffu + ((u >> 16) & 1u)) >> 16; }
__device__ __forceinline__ unsigned pk2(float lo, float hi) { return f2bf(lo) | (f2bf(hi) << 16); }

__device__ __forceinline__ void p0_transpose_item(const float* W, int K, int N, bf16_t* WT, int row_off, LAS float* scr, int item, int lane) {
    const int nblk = N / 32, kb = item / nblk, nb = item % nblk, k0 = 64 * kb, n0 = 32 * nb;
#pragma unroll 8
    for (int i = 0; i < 32; ++i) { const int kk = 2 * i + (lane >> 5); scr[kk * 33 + (lane & 31)] = W[(size_t)(k0 + kk) * N + n0 + (lane & 31)]; }
    asm volatile("s_waitcnt lgkmcnt(0)" ::: "memory");
    const int c = lane & 7;
#pragma unroll
    for (int j = 0; j < 4; ++j) { const int n = (lane >> 3) + 8 * j; const LAS float* s = scr + (8 * c) * 33 + n;
        u32x4 o; o.x = pk2(s[0 * 33], s[1 * 33]); o.y = pk2(s[2 * 33], s[3 * 33]); o.z = pk2(s[4 * 33], s[5 * 33]); o.w = pk2(s[6 * 33], s[7 * 33]);
        *(u32x4*)(WT + (size_t)(row_off + n0 + n) * K + k0 + 8 * c) = o; }
    asm volatile("s_waitcnt lgkmcnt(0)" ::: "memory");
}

#define XB_TMO      128
#define XB_XCNT(j)  (256  + 64 * (j))
#define XB_XSUB(j)  (1280 + 64 * (j))
#define XB_XGEN(j)  (2304 + 64 * (j))
#define XB_TOP      3328
#define XB_TOPGEN   3392
#define XCD_BAR_WORDS 3456
#define XB_SPIN_CAP (1u << 18)

__device__ __forceinline__ unsigned xb_ld(unsigned* p)              { return __hip_atomic_load(p, __ATOMIC_RELAXED, __HIP_MEMORY_SCOPE_AGENT); }
__device__ __forceinline__ unsigned xb_add(unsigned* p, unsigned v) { return __hip_atomic_fetch_add(p, v, __ATOMIC_RELAXED, __HIP_MEMORY_SCOPE_AGENT); }
__device__ __forceinline__ unsigned xb_xcc_id() { return (unsigned)__builtin_amdgcn_s_getreg((3 << 11) | 20) & 0xFu; }
#define XB_SPIN(cond, bar) do { unsigned _sp = 0; while (cond) { __builtin_amdgcn_s_sleep(1); \
    if ((++_sp & 255u) == 0u) { if (xb_ld(&(bar)[XB_TMO])) break; if (_sp > XB_SPIN_CAP) { atomicAdd(&(bar)[XB_TMO], 1u); break; } } } } while (0)

struct XcdBarrier {
    unsigned* bar; unsigned x;
    volatile LAS unsigned* st;
};

__device__ __forceinline__ XcdBarrier xcd_barrier_post(unsigned* bar, volatile LAS unsigned* st) {
    XcdBarrier b; b.bar = bar; b.x = xb_xcc_id(); b.st = st;
    if (threadIdx.x == 0) (void)xb_add(&bar[XB_XCNT(b.x)], 1u);
    return b;
}
__device__ __forceinline__ void xcd_barrier_complete(unsigned* bar, unsigned x, unsigned& nloc, unsigned& nx) {
    const unsigned G = gridDim.x * gridDim.y * gridDim.z;
    unsigned sum, cnt, mine, sp = 0u;
    for (;;) {
        sum = 0u; cnt = 0u; mine = 0u;
#pragma unroll
        for (unsigned j = 0; j < 16; ++j) { const unsigned c = xb_ld(&bar[XB_XCNT(j)]); sum += c; cnt += (c > 0u) ? 1u : 0u; mine = (j == x) ? c : mine; }
        if (sum == G) break;
        __builtin_amdgcn_s_sleep(1);
        if ((++sp & 255u) == 0u) { if (xb_ld(&bar[XB_TMO])) break; if (sp > XB_SPIN_CAP) { atomicAdd(&bar[XB_TMO], 1u); break; } }
    }
    nloc = mine > 0u ? mine : 1u; nx = cnt > 0u ? cnt : 1u;
}

__device__ __forceinline__ void xcd_barrier(const XcdBarrier& b) {
    asm volatile("s_waitcnt vmcnt(0)" ::: "memory");
    __syncthreads();
    if (threadIdx.x == 0) {
        unsigned* bar = b.bar;
        __builtin_amdgcn_s_waitcnt(0);
        unsigned nloc = b.st[0], nx = b.st[1];
        if (nloc == 0u) { xcd_barrier_complete(bar, b.x, nloc, nx); b.st[0] = nloc; b.st[1] = nx; }
        const unsigned old = xb_add(&bar[XB_XSUB(b.x)], 1u);
        const unsigned gen = old / nloc;
        if (old + 1u == (gen + 1u) * nloc) {
            __builtin_amdgcn_fence(__ATOMIC_RELEASE, "agent");
            asm volatile("s_waitcnt vmcnt(0)" ::: "memory");
            const unsigned og = xb_add(&bar[XB_TOP], 1u);
            const unsigned tg = og / nx;
            if (og + 1u == (tg + 1u) * nx) xb_add(&bar[XB_TOPGEN], 1u);
            else XB_SPIN(xb_ld(&bar[XB_TOPGEN]) == tg, bar);
            __builtin_amdgcn_fence(__ATOMIC_ACQUIRE, "agent");
            xb_add(&bar[XB_XGEN(b.x)], 1u);
            asm volatile("s_waitcnt vmcnt(0)" ::: "memory");
        } else {
            XB_SPIN(xb_ld(&bar[XB_XGEN(b.x)]) == gen, bar);
            __builtin_amdgcn_fence(__ATOMIC_ACQUIRE, "agent");
            asm volatile("s_waitcnt vmcnt(0)" ::: "memory");
        }
    }
    __syncthreads();
}

struct Args {
    const float* x; const float* c; const float* norm_gain; const float* w_ada; const float* b_ada; const float* w_in; const float* pool_w; const float* pool_scale;
    const float* w_a; const float* w_b; const float* w_out; const float* final_gain; float* out; unsigned char* ws;
};

__device__ __forceinline__ void p0_prologue(const Args& a, LAS unsigned char* lds, int tid, int lane, int wave) {
    const int blk = blockIdx.x;
    if (blk < 192) {
        LAS float* sc = (LAS float*)lds;
        for (int i0 = tid; i0 < NB * DM; i0 += 8 * NTHREADS) { float cv[8];
#pragma unroll
            for (int j = 0; j < 8; ++j) cv[j] = a.c[i0 + j * NTHREADS];
#pragma unroll
            for (int j = 0; j < 8; ++j) { const int i = i0 + j * NTHREADS, b = i >> 10, k = i & 1023; sc[k * 36 + b] = cv[j] * pg8::fast_sigmoid(cv[j]); } }
        __syncthreads();
        const int kpart = tid >> 4, col = tid & 15, n = blk * 16 + col;
        float acc[32];
#pragma unroll
        for (int b = 0; b < 32; ++b) acc[b] = 0.f;
        float wv[32];
#pragma unroll
        for (int kk = 0; kk < 32; ++kk) wv[kk] = a.w_ada[(size_t)(kpart * 32 + kk) * 3072 + n];
#pragma unroll
        for (int kk = 0; kk < 32; ++kk) { const int k = kpart * 32 + kk; const float w = wv[kk];
#pragma unroll
            for (int b4 = 0; b4 < 8; ++b4) { const f32x4 s = *(const LAS f32x4*)(sc + k * 36 + 4 * b4); acc[4 * b4] += s[0] * w; acc[4 * b4 + 1] += s[1] * w; acc[4 * b4 + 2] += s[2] * w; acc[4 * b4 + 3] += s[3] * w; } }
        __syncthreads();
        LAS float* red = (LAS float*)lds;
#pragma unroll
        for (int b = 0; b < 32; ++b) red[(kpart * 32 + b) * 16 + col] = acc[b];
        __syncthreads();
        { const int b = tid >> 4; float s = 0.f;
            for (int kp = 0; kp < 32; ++kp) s += red[kp * 512 + tid];
            ((float*)(a.ws + WS_MOD))[(size_t)b * 3072 + n] = s + a.b_ada[n]; }
        __syncthreads();
    }
    for (int tile = blk; tile < 256; tile += gridDim.x) {
        const int g = tile >> 6, k0 = ((tile >> 2) & 15) * 64, n0 = (tile & 3) * 64;
        LAS float* As = (LAS float*)lds;
        LAS float* Bs = (LAS float*)(lds + 65792);
        for (int i0 = tid; i0 < 64 * 256; i0 += 8 * NTHREADS) { float va[8], vb[8];
#pragma unroll
            for (int j8 = 0; j8 < 8; ++j8) { const int i = i0 + j8 * NTHREADS; va[j8] = a.w_in[(size_t)(k0 + (i >> 8)) * NPROJ + 4096 + g * 256 + (i & 255)]; vb[j8] = a.pool_w[((size_t)g * 256 + (i >> 6)) * 256 + n0 + (i & 63)]; }
#pragma unroll
            for (int j8 = 0; j8 < 8; ++j8) { const int i = i0 + j8 * NTHREADS; As[(i >> 8) * 257 + (i & 255)] = va[j8]; Bs[(i >> 6) * 64 + (i & 63)] = vb[j8]; } }
        __syncthreads();
        const int kk = tid >> 3, nn = (tid & 7) * 8;
        f32x4 c0 = {0.f, 0.f, 0.f, 0.f}, c1 = {0.f, 0.f, 0.f, 0.f};
#pragma unroll 4
        for (int j = 0; j < 256; ++j) { const float av = As[kk * 257 + j]; const f32x4 b0 = *(const LAS f32x4*)(Bs + j * 64 + nn), b1 = *(const LAS f32x4*)(Bs + j * 64 + nn + 4); c0 += b0 * av; c1 += b1 * av; }
        bf16_t* WT = (bf16_t*)(a.ws + WS_WIN) + (size_t)(4096 + g * 256 + n0 + nn) * 1024 + k0 + kk;
#pragma unroll
        for (int e = 0; e < 4; ++e) { WT[(size_t)e * 1024] = (bf16_t)f2bf(c0[e]); WT[(size_t)(e + 4) * 1024] = (bf16_t)f2bf(c1[e]); }
        __syncthreads();
    }
    {
        LAS float* scr = (LAS float*)(lds + wave * 16384);
        const int gw = blk * NWAVES + wave, NGW = gridDim.x * NWAVES;
        constexpr int I_IN = (DM / 64) * (NPROJ / 32), I_SQ = (DM / 64) * (DM / 32);
        for (int it = gw; it < I_IN + 3 * I_SQ; it += NGW) {
            int r = it;
            if (r < I_IN) { const int nb = r % (NPROJ / 32); if (nb < 128 || nb >= 160) p0_transpose_item(a.w_in, DM, NPROJ, (bf16_t*)(a.ws + WS_WIN), 0, scr, r, lane); continue; } r -= I_IN;
            if (r < I_SQ) { p0_transpose_item(a.w_a, DM, DM, (bf16_t*)(a.ws + WS_WA), 0, scr, r, lane); continue; } r -= I_SQ;
            if (r < I_SQ) { p0_transpose_item(a.w_b, DM, DM, (bf16_t*)(a.ws + WS_WB), 0, scr, r, lane); continue; } r -= I_SQ;
            p0_transpose_item(a.w_out, DM, DM, (bf16_t*)(a.ws + WS_WO), 0, scr, r, lane);
        }
    }
}

__device__ __forceinline__ void p1_prenorm(const Args& a, int lane_in, int wave) {
    int lane = lane_in; asm volatile("" : "+v"(lane));
    const int gw = blockIdx.x * NWAVES + wave, NGW = gridDim.x * NWAVES;
    bf16_t* H = (bf16_t*)(a.ws + WS_H);
    for (int rb = gw; rb < MTOK / 32; rb += NGW) {
        const int b = rb >> 6; const float* mod = (const float*)(a.ws + WS_MOD) + (size_t)b * 3072;
        f32x4 ca[4], cs[4];
#pragma unroll
        for (int j = 0; j < 4; ++j) { const int c = 4 * lane + 256 * j; const f32x4 g = *(const f32x4*)(a.norm_gain + c), sc = *(const f32x4*)(mod + 1024 + c); ca[j] = g * (sc + 1.0f); cs[j] = *(const f32x4*)(mod + c); }
#pragma unroll 2
        for (int r = 0; r < 32; ++r) { const size_t row = (size_t)rb * 32 + r; const f32x4* xr = (const f32x4*)(a.x + row * DM) + lane;
            f32x4 v[4]; float s = 0.f;
#pragma unroll
            for (int j = 0; j < 4; ++j) { v[j] = xr[64 * j]; s += (v[j].x * v[j].x + v[j].y * v[j].y) + (v[j].z * v[j].z + v[j].w * v[j].w); }
            const float rstd = 1.0f / sqrtf(wave_sum(s) * (1.0f / DM) + EPS);
            u32x2* o8 = (u32x2*)(H + row * DM) + lane;
#pragma unroll
            for (int j = 0; j < 4; ++j) { const f32x4 o = v[j] * rstd * ca[j] + cs[j]; u32x2 w; w.x = cvt_pk_bf16(o.x, o.y); w.y = cvt_pk_bf16(o.z, o.w); o8[64 * j] = w; } }
    }
}
__device__ __forceinline__ void p6_final_norm(const Args& a, int lane_in, int wave) {
    int lane = lane_in; asm volatile("" : "+v"(lane));
    const int gw = blockIdx.x * NWAVES + wave, NGW = gridDim.x * NWAVES;
    f32x4 fg[4];
#pragma unroll
    for (int j = 0; j < 4; ++j) fg[j] = *(const f32x4*)(a.final_gain + 4 * lane + 256 * j);
    for (int rb = gw; rb < MTOK / 32; rb += NGW) {
#pragma unroll 2
        for (int r = 0; r < 32; ++r) { const size_t row = (size_t)rb * 32 + r; f32x4* yr = (f32x4*)(a.out + row * DM) + lane;
            f32x4 v[4]; float s = 0.f;
#pragma unroll
            for (int j = 0; j < 4; ++j) { v[j] = yr[64 * j]; s += (v[j].x * v[j].x + v[j].y * v[j].y) + (v[j].z * v[j].z + v[j].w * v[j].w); }
            const float rstd = 1.0f / sqrtf(wave_sum(s) * (1.0f / DM) + EPS);
#pragma unroll
            for (int j = 0; j < 4; ++j) yr[64 * j] = v[j] * rstd * fg[j]; }
    }
}

__device__ __forceinline__ bf16x8 ldg8(const bf16_t* p) { return *(const bf16x8*)p; }
template <bool MASKED>
__device__ __forceinline__ void attn_tile_math(const f32x4 (&s)[4][2], int ks, int t0, int ql, int fq, float (&rp)[2], bf16x8 (&pf)[2][2]) {
    constexpr float C2 = 0.125f * 1.4426950408889634f;
#pragma unroll
    for (int gq = 0; gq < 2; ++gq) {
        const int t = t0 + 16 * gq + ql;
        float om[16], be[16];
#pragma unroll
        for (int b = 0; b < 4; ++b)
#pragma unroll
            for (int i = 0; i < 4; ++i) { const int e = 4 * b + i;
                const float xs = fminf(s[b][gq][i] * C2, 60.f), ex = __builtin_amdgcn_exp2f(xs), omv = __builtin_amdgcn_rcpf(1.0f + ex);
                if (MASKED) { const int key = ks + 16 * fq + e; const bool valid = (unsigned)key < (unsigned)t;     om[e] = valid ? omv : 1.0f; be[e] = valid ? ex * omv : 0.0f; }
                else { om[e] = omv; be[e] = ex * omv; } }
        float sp = 1.0f;
#pragma unroll
        for (int e = 15; e >= 0; --e) { const float tmp = om[e]; om[e] = sp; sp *= tmp; }
        const float T0 = __shfl(sp, ql), T1 = __shfl(sp, ql + 16), T2 = __shfl(sp, ql + 32), T3 = __shfl(sp, ql + 48);
        const float X = (fq < 1 ? T1 : 1.0f) * (fq < 2 ? T2 : 1.0f) * (fq < 3 ? T3 : 1.0f);
        const float f = X * rp[gq];
        rp[gq] *= (T0 * T1) * (T2 * T3);
        float w[16];
#pragma unroll
        for (int e = 0; e < 16; ++e) w[e] = be[e] * (om[e] * f);
#pragma unroll
        for (int hv = 0; hv < 2; ++hv) { u32x4 pw; pw.x = cvt_pk_bf16(w[8 * hv], w[8 * hv + 1]); pw.y = cvt_pk_bf16(w[8 * hv + 2], w[8 * hv + 3]); pw.z = cvt_pk_bf16(w[8 * hv + 4], w[8 * hv + 5]); pw.w = cvt_pk_bf16(w[8 * hv + 6], w[8 * hv + 7]);
            pf[hv][gq] = __builtin_bit_cast(bf16x8, pw); }
        __builtin_amdgcn_sched_barrier(0);
    }
}
__device__ __forceinline__ bf16x8 ldu8(const char* ubase, unsigned voff) { return *(const bf16x8*)(ubase + voff); }
#define ATT_LOADV(ks_) do { _Pragma("unroll") for (int hv = 0; hv < 2; ++hv) { int key0 = (ks_) + 16 * fq + 8 * hv; key0 = key0 < 0 ? 0 : key0; const unsigned vo = vlane + (unsigned)key0 * 2u; \
        _Pragma("unroll") for (int db = 0; db < 4; ++db) vf[db][hv] = ldu8(Vu, vo + db * 65536u); } } while (0)
#define ATT_QK() do { _Pragma("unroll") for (int b = 0; b < 4; ++b) _Pragma("unroll") for (int gq = 0; gq < 2; ++gq) { \
        s[b][gq] = __builtin_amdgcn_mfma_f32_16x16x32_bf16(kf[b][0], qf[gq][0], (f32x4){0.f, 0.f, 0.f, 0.f}, 0, 0, 0); \
        s[b][gq] = __builtin_amdgcn_mfma_f32_16x16x32_bf16(kf[b][1], qf[gq][1], s[b][gq], 0, 0, 0); } } while (0)
#define ATT_PV() do { _Pragma("unroll") for (int db = 0; db < 4; ++db) _Pragma("unroll") for (int gq = 0; gq < 2; ++gq) { \
        o[db][gq] = __builtin_amdgcn_mfma_f32_16x16x32_bf16(vf[db][0], pf[0][gq], o[db][gq], 0, 0, 0); \
        o[db][gq] = __builtin_amdgcn_mfma_f32_16x16x32_bf16(vf[db][1], pf[1][gq], o[db][gq], 0, 0, 0); } } while (0)
#define ATT_KPREF(ku_, ks_, slotoff_) do { _Pragma("unroll") for (int b = 0; b < 4; ++b) { int key = (ks_) + kperm + 4 * b; key = key < 0 ? 0 : key; const unsigned ko = (unsigned)key * 2048u + klane; \
        _Pragma("unroll") for (int kh = 0; kh < 2; ++kh) __builtin_amdgcn_global_load_lds((const unsigned*)((ku_) + ko + kh * 64), (LAS unsigned*)(wlds + (slotoff_) + (b * 2 + kh) * 1024), 16, 0, 0); } } while (0)
#define ATT_QPREF(qu_, slotoff_) do { _Pragma("unroll") for (int gq = 0; gq < 2; ++gq) _Pragma("unroll") for (int kh = 0; kh < 2; ++kh) \
        __builtin_amdgcn_global_load_lds((const unsigned*)((qu_) + qlane + gq * 32768u + kh * 64), (LAS unsigned*)(wlds + (slotoff_) + (gq * 2 + kh) * 1024), 16, 0, 0); } while (0)
#define ATT_ZPREF(zu_, slotoff_) do { _Pragma("unroll") for (int p = 0; p < 4; ++p) \
        __builtin_amdgcn_global_load_lds((const unsigned*)((zu_) + zlane + p * 16384u), (LAS unsigned*)(wlds + (slotoff_) + 4096 + p * 1024), 16, 0, 0); } while (0)
__device__ __forceinline__ void attn_wave(const bf16_t* __restrict__ Q, const bf16_t* __restrict__ K, const bf16_t* __restrict__ VT, const bf16_t* __restrict__ ZA, bf16_t* __restrict__ AG,
                                          LAS unsigned char* wlds, int gw, int NGW, int lane_in) {
    int lane = lane_in; asm volatile("" : "+v"(lane));
    constexpr int NU = BPC * NH * 64;
    constexpr float THR = 3.5527136788005009e-15f;
    const int ql = lane & 15, fq = lane >> 4, kperm = 16 * (ql >> 2) + (ql & 3);
    const unsigned klane = 16u * fq, vlane = 4096u * ql, qlane = 2048u * ql + 16u * fq, zlane = 2048u * (lane >> 3) + 16u * (lane & 7), olane = 2048u * ql + 8u * fq;
    int U = gw; if (U >= NU) return;
    int slot = 0;
    { const int bh = U >> 6, t0 = (U & 63) * 32; const size_t rowbase = (size_t)(bh >> 4) * SEQ; const int h = bh & 15;
      const char* Ku = (const char*)(K + rowbase * DM + h * 64); ATT_KPREF(Ku, t0 - 32, 0);
      const char* Qu = (const char*)(Q + (rowbase + t0) * DM + h * 64); ATT_QPREF(Qu, 8192); }
    for (; U < NU; U += NGW) {
        const int bh = U >> 6, t0 = (U & 63) * 32, bl = bh >> 4, h = bh & 15;
        const size_t rowbase = (size_t)bl * SEQ;
        const char* Ku = (const char*)(K + rowbase * DM + h * 64);
        const char* Vu = (const char*)(VT + ((size_t)bl * DM + h * 64) * SEQ);
        const int np = (t0 >= 64) ? 2 : 1;
        const int Un = U + NGW; const bool has_next = Un < NU;
        f32x4 o[4][2];
#pragma unroll
        for (int db = 0; db < 4; ++db) { o[db][0] = (f32x4){0.f, 0.f, 0.f, 0.f}; o[db][1] = (f32x4){0.f, 0.f, 0.f, 0.f}; }
        float rp[2] = {1.f, 1.f};
        bf16x8 qf[2][2];
        asm volatile("s_waitcnt vmcnt(0)" ::: "memory");
        { const LAS unsigned char* qp_ = wlds + (slot ^ 1) * 8192 + lane * 16;
#pragma unroll
          for (int gq = 0; gq < 2; ++gq)
#pragma unroll
              for (int kh = 0; kh < 2; ++kh) qf[gq][kh] = *(const LAS bf16x8*)(qp_ + (gq * 2 + kh) * 1024); }
        asm volatile("s_waitcnt lgkmcnt(0)" ::: "memory");
        for (int jt = 0; jt < np; ++jt) {
            const int ks = t0 - 32 - 64 * jt;
            bf16x8 kf[4][2], vf[4][2], pf[2][2]; f32x4 s[4][2];
            asm volatile("s_waitcnt vmcnt(0)" ::: "memory");
            { const LAS unsigned char* sp_ = wlds + slot * 8192 + lane * 16;
#pragma unroll
              for (int b = 0; b < 4; ++b)
#pragma unroll
                  for (int kh = 0; kh < 2; ++kh) kf[b][kh] = *(const LAS bf16x8*)(sp_ + (b * 2 + kh) * 1024); }
            asm volatile("s_waitcnt lgkmcnt(0)" ::: "memory");
            ATT_LOADV(ks);
            if (jt + 1 < np) { ATT_KPREF(Ku, ks - 64, (slot ^ 1) * 8192); }
            else {
                if (has_next) { const int bhn = Un >> 6, t0n = (Un & 63) * 32, hn = bhn & 15; const size_t rbn = (size_t)(bhn >> 4) * SEQ;
                    const char* Kun = (const char*)(K + rbn * DM + hn * 64); ATT_KPREF(Kun, t0n - 32, (slot ^ 1) * 8192);
                    const char* Qun = (const char*)(Q + (rbn + t0n) * DM + hn * 64); ATT_QPREF(Qun, slot * 8192); }
                { const char* Zu = (const char*)(ZA + (rowbase + t0) * DM + h * 64); ATT_ZPREF(Zu, slot * 8192); }
            }
            ATT_QK();
            if (jt == 0 || ks < 0) attn_tile_math<true>(s, ks, t0, ql, fq, rp, pf); else attn_tile_math<false>(s, ks, t0, ql, fq, rp, pf);
            ATT_PV();
            slot ^= 1;
        }
        for (int jt = np;; ++jt) {
            const int ks = t0 - 32 - 64 * jt;
            if (ks + 64 <= 0) break;
            if (__all(fmaxf(rp[0], rp[1]) < THR)) break;
            bf16x8 kf[4][2], vf[4][2], pf[2][2]; f32x4 s[4][2];
#pragma unroll
            for (int b = 0; b < 4; ++b) { int key = ks + kperm + 4 * b; key = key < 0 ? 0 : key; const unsigned ko = (unsigned)key * 2048u + klane;
#pragma unroll
                for (int kh = 0; kh < 2; ++kh) kf[b][kh] = ldu8(Ku, ko + kh * 64); }
            ATT_LOADV(ks);
            ATT_QK();
            attn_tile_math<true>(s, ks, t0, ql, fq, rp, pf);
            ATT_PV();
        }
        asm volatile("s_waitcnt vmcnt(0)" ::: "memory");
        const LAS unsigned char* zl_ = wlds + (slot ^ 1) * 8192 + 4096 + ql * 128 + fq * 8;
        char* Au = (char*)(AG + (rowbase + t0) * DM + h * 64);
#pragma unroll
        for (int gq = 0; gq < 2; ++gq)
#pragma unroll
            for (int db = 0; db < 4; ++db) {
                const u32x2 z = *(const LAS u32x2*)(zl_ + gq * 2048 + db * 32); const f32x4 ov = o[db][gq];
                u32x2 w; w.x = cvt_pk_bf16(ov[0] * bf_lo(z.x), ov[1] * bf_hi(z.x)); w.y = cvt_pk_bf16(ov[2] * bf_lo(z.y), ov[3] * bf_hi(z.y));
                *(u32x2*)(Au + olane + gq * 32768u + db * 32) = w; }
        asm volatile("s_waitcnt lgkmcnt(0)" ::: "memory");
    }
    asm volatile("s_waitcnt vmcnt(0)" ::: "memory");
}
template <int HB>
__device__ __forceinline__ void pool_unit(const bf16_t* __restrict__ Y, const bf16_t* __restrict__ ZB, const float* __restrict__ pscale, bf16_t* __restrict__ BG, int bl, int t0, int lane) {
    constexpr int WA = HB ? 8 : 2, WB = HB ? 16 : 4, HL = WB;
    const bool hiL = lane >= 32; const int win = hiL ? WB : WA;
    const int ch = HB * 512 + lane * 8;
    const char* Yu = (const char*)(Y + (size_t)bl * SEQ * DM); const char* Zu = (const char*)(ZB + (size_t)bl * SEQ * DM); char* Bu = (char*)(BG + (size_t)bl * SEQ * DM);
    const unsigned lo = (unsigned)ch * 2u;
    u32x4 Yr[HL + 16], Zr[16];
    if (t0 > 0) {
#pragma unroll
        for (int i = 0; i < HL; ++i) Yr[i] = *(const u32x4*)(Yu + (unsigned)(t0 - HL + i) * 2048u + lo);
    } else {
#pragma unroll
        for (int i = 0; i < HL; ++i) Yr[i] = (u32x4){0u, 0u, 0u, 0u};
    }
#pragma unroll
    for (int i = 0; i < 16; ++i) { Yr[HL + i] = *(const u32x4*)(Yu + (unsigned)(t0 + i) * 2048u + lo); Zr[i] = *(const u32x4*)(Zu + (unsigned)(t0 + i) * 2048u + lo); }
    const f32x4 ps0 = *(const f32x4*)(pscale + ch), ps1 = *(const f32x4*)(pscale + ch + 4);
    float run[8];
#pragma unroll
    for (int c = 0; c < 8; ++c) run[c] = 0.f;
#pragma unroll
    for (int j = 1; j <= WB; ++j) { const u32x4 w = Yr[HL - j]; const float m = (j <= WA) ? 1.0f : (hiL ? 1.0f : 0.0f);
#pragma unroll
        for (int q = 0; q < 4; ++q) { run[2 * q] += m * bf_lo(w[q]); run[2 * q + 1] += m * bf_hi(w[q]); } }
#pragma unroll
    for (int r = 0; r < 16; ++r) {
        const u32x4 ya = Yr[HL + r], yoA = Yr[HL + r - WA], yoB = Yr[HL + r - WB], zb = Zr[r];
        const int t = t0 + r; const int cnt = (t + 1 < win) ? (t + 1) : win; const float rc = __builtin_amdgcn_rcpf((float)cnt);
        float ov[8];
#pragma unroll
        for (int q = 0; q < 4; ++q) { const unsigned yo = hiL ? yoB[q] : yoA[q];
            const float y0 = bf_lo(ya[q]), y1 = bf_hi(ya[q]);
            run[2 * q] += y0 - bf_lo(yo); run[2 * q + 1] += y1 - bf_hi(yo);
            const float p0 = (q < 2) ? ps0[2 * q] : ps1[2 * q - 4], p1 = (q < 2) ? ps0[2 * q + 1] : ps1[2 * q - 3];
            ov[2 * q] = (run[2 * q] * rc - y0) * p0 * bf_lo(zb[q]); ov[2 * q + 1] = (run[2 * q + 1] * rc - y1) * p1 * bf_hi(zb[q]); }
        u32x4 w; w.x = cvt_pk_bf16(ov[0], ov[1]); w.y = cvt_pk_bf16(ov[2], ov[3]); w.z = cvt_pk_bf16(ov[4], ov[5]); w.w = cvt_pk_bf16(ov[6], ov[7]);
        *(u32x4*)(Bu + (unsigned)t * 2048u + lo) = w;
    }
}
__device__ __forceinline__ void pool_wave(const bf16_t* __restrict__ Y, const bf16_t* __restrict__ ZB, const float* __restrict__ pscale, bf16_t* __restrict__ BG, int gw, int NGW, int lane_in) {
    int lane = lane_in; asm volatile("" : "+v"(lane));
    for (int U = gw; U < BPC * 2 * 128; U += NGW) {
        const int bl = U >> 8, half = (U >> 7) & 1, t0 = (U & 127) * 16;
        if (half) pool_unit<1>(Y, ZB, pscale, BG, bl, t0, lane); else pool_unit<0>(Y, ZB, pscale, BG, bl, t0, lane);
    }
}

__global__ void __launch_bounds__(NTHREADS) hybrid_fwd(Args a) {
    extern __shared__ __attribute__((aligned(16))) unsigned char lds_raw[];
    LAS unsigned char* lds = (LAS unsigned char*)lds_raw;
    cg::grid_group grid = cg::this_grid();
    const int tid = threadIdx.x, lane = tid & 63, wave = __builtin_amdgcn_readfirstlane(tid >> 6);
    const int G = gridDim.x;
    unsigned char* ws = a.ws;
    bf16_t* H = (bf16_t*)(ws + WS_H); bf16_t* PROJ = (bf16_t*)(ws + WS_PROJ);
    bf16_t* AGb = (bf16_t*)(ws + WS_AG); bf16_t* BGb = (bf16_t*)(ws + WS_BG); bf16_t* MG = (bf16_t*)(ws + WS_MG);
    const bf16_t* WIN = (const bf16_t*)(ws + WS_WIN); const bf16_t* WA = (const bf16_t*)(ws + WS_WA); const bf16_t* WB = (const bf16_t*)(ws + WS_WB); const bf16_t* WO = (const bf16_t*)(ws + WS_WO);

    volatile LAS unsigned* MISC = (volatile LAS unsigned*)(lds + MISC_OFF);
    if (tid < 64) MISC[tid] = 0u;
    __syncthreads();
    if (a.ws == nullptr) grid.sync();
    const XcdBarrier bar = xcd_barrier_post((unsigned*)ws, MISC + 8);
#define GRID_BAR() xcd_barrier(bar)
    p0_prologue(a, lds, tid, lane, wave);
    GRID_BAR();
    p1_prenorm(a, lane, wave);
    GRID_BAR();
    for (int ch = 0; ch < NCHUNK; ++ch) {
        { pg8::Gemm g{H + (size_t)ch * MC * DM, nullptr, WIN, nullptr, MC, NPROJ, DM}; pg8::StaticOrder S; S.init(MC, NPROJ, G, (int)blockIdx.x, 0);
          pg8::EpiProj E{PROJ}; pg8::gemm_phase<pg8::EpiProj, true, true>(lds, g, S, E); }
        GRID_BAR();
        { const int gw = blockIdx.x * NWAVES + wave, NGW = G * NWAVES;
          const bf16_t* Qb = PROJ; const bf16_t* Kb = PROJ + pg8::SEG_ELEMS; const bf16_t* VTb = PROJ + 2 * pg8::SEG_ELEMS; const bf16_t* ZAb = PROJ + 3 * pg8::SEG_ELEMS;
          const bf16_t* Yb = PROJ + 4 * pg8::SEG_ELEMS; const bf16_t* ZBb = PROJ + 5 * pg8::SEG_ELEMS;
          if (wave < 4) pool_wave(Yb, ZBb, a.pool_scale, BGb, gw, NGW, lane);
          attn_wave(Qb, Kb, VTb, ZAb, AGb, lds + wave * 16384, gw, NGW, lane);
          if (wave >= 4) pool_wave(Yb, ZBb, a.pool_scale, BGb, gw, NGW, lane); }
        GRID_BAR();
        { pg8::Gemm g{AGb, BGb, WA, WB, MC, DM, DM}; pg8::StaticOrder S; S.init(MC, DM, G, (int)blockIdx.x, 1);
          pg8::EpiMerge E{PROJ + 6 * pg8::SEG_ELEMS, PROJ + 7 * pg8::SEG_ELEMS, MG}; pg8::gemm_phase<pg8::EpiMerge, true, true>(lds, g, S, E); }
        GRID_BAR();
        { pg8::Gemm g{MG, nullptr, WO, nullptr, MC, DM, DM}; pg8::StaticOrder S; S.init(MC, DM, G, (int)blockIdx.x, 0);
          pg8::EpiOut E{a.x, (const float*)(ws + WS_MOD), a.out, ch * MC}; pg8::gemm_phase<pg8::EpiOut, true, true>(lds, g, S, E); }
    }
    GRID_BAR();
    p6_final_norm(a, lane, wave);
}

extern "C" void kernel_launch(void* const* d_in, const int* in_sizes, int n_in, void* d_out, int out_size, void* d_ws, size_t ws_size, hipStream_t stream) {
    static int grid = 0;
    if (grid == 0) {
        if (n_in != 12 || in_sizes[0] != MTOK * DM || out_size != MTOK * DM || ws_size < WS_END) { fprintf(stderr, "kernel_launch: unexpected shapes (n_in %d, in0 %d, out %d, ws %zu)\n", n_in, n_in > 0 ? in_sizes[0] : -1, out_size, ws_size); grid = -1; return; }
        int dev = 0, cus = 0, per_cu = 0;
        if (hipGetDevice(&dev) != hipSuccess || hipDeviceGetAttribute(&cus, hipDeviceAttributeMultiprocessorCount, dev) != hipSuccess) { grid = -1; return; }
        if (hipFuncSetAttribute((const void*)hybrid_fwd, hipFuncAttributeMaxDynamicSharedMemorySize, LDS_BYTES) != hipSuccess) { fprintf(stderr, "kernel_launch: hipFuncSetAttribute failed\n"); grid = -1; return; }
        if (hipOccupancyMaxActiveBlocksPerMultiprocessor(&per_cu, (const void*)hybrid_fwd, NTHREADS, LDS_BYTES) != hipSuccess || per_cu < 1) { fprintf(stderr, "kernel_launch: occupancy query says %d\n", per_cu); per_cu = 1; }
        (void)hipGetLastError();
        grid = cus;
    }
    if (grid < 0) return;
    Args a{};
    a.x = (const float*)d_in[0]; a.c = (const float*)d_in[1]; a.norm_gain = (const float*)d_in[2]; a.w_ada = (const float*)d_in[3]; a.b_ada = (const float*)d_in[4];
    a.w_in = (const float*)d_in[5]; a.pool_w = (const float*)d_in[6]; a.pool_scale = (const float*)d_in[7]; a.w_a = (const float*)d_in[8]; a.w_b = (const float*)d_in[9];
    a.w_out = (const float*)d_in[10]; a.final_gain = (const float*)d_in[11]; a.out = (float*)d_out; a.ws = (unsigned char*)d_ws;
    if (hipMemsetAsync(d_ws, 0, 65536, stream) != hipSuccess) { fprintf(stderr, "kernel_launch: memset failed\n"); return; }
    void* args[] = {&a};
    hipError_t e = hipLaunchCooperativeKernel((const void*)hybrid_fwd, dim3(grid), dim3(NTHREADS), args, LDS_BYTES, stream);
    if (e != hipSuccess) fprintf(stderr, "kernel_launch: cooperative launch failed: %s (grid %d)\n", hipGetErrorString(e), grid);
}
```
